# Optimizing an MI355X kernel written in HIP

```python
import math
import jax, jax.numpy as jnp
from jax import lax
import numpy as np

D_MODEL = 2048
BATCH = 16
SEQ = 2048
DEPTH = 2

N_META = 16
GRID_W = 64
ROPE_THETA = 10000.0
EPS = 1e-6

RET_HEADS = 8
RET_DK = 64
RET_DV = 128
RET_CHUNK = 128

DIFF_HEADS = 4
DIFF_DH = 128
DIFF_DV = 2 * DIFF_DH
Q_BLOCK = 128

NA_HEADS = 16
NA_DH = 64
NA_WIN_R = 8
NA_WIN_C = 16

RET_OUT_W = RET_HEADS * RET_DV
DIFF_OUT_W = DIFF_HEADS * DIFF_DV
NA_OUT_W = NA_HEADS * NA_DH

D_FF = 5504
CONV_W = 3

IN_SIZES = (
    RET_HEADS * RET_DK, RET_HEADS * RET_DK, RET_HEADS * RET_DV, RET_HEADS * RET_DV,
    2 * DIFF_HEADS * DIFF_DH, 2 * DIFF_HEADS * DIFF_DH, DIFF_HEADS * DIFF_DV,
    NA_HEADS * NA_DH, NA_HEADS * NA_DH, NA_HEADS * NA_DH,
    3 * D_MODEL,
)
IN_WIDTH = sum(IN_SIZES)

kernel_name = "hybrid_retention_diffattn_natten_encoder"

f32 = jnp.float32


def rms_norm(x, g):
    xf = x.astype(f32)
    y = xf * lax.rsqrt(jnp.mean(xf * xf, axis=-1, keepdims=True) + EPS)
    return (y * g.astype(f32)).astype(x.dtype)


def rope(x, pos):
    d = x.shape[-1]
    inv = jnp.power(ROPE_THETA, -jnp.arange(0, d, 2, dtype=f32) / d)
    ang = pos.astype(f32)[:, None] * inv[None, :]
    cos, sin = jnp.cos(ang), jnp.sin(ang)
    xf = x.astype(f32)
    x1, x2 = xf[..., : d // 2], xf[..., d // 2:]
    return jnp.concatenate([x1 * cos - x2 * sin, x1 * sin + x2 * cos], axis=-1).astype(x.dtype)


def to_heads(t, n):
    b, l, w = t.shape
    return t.reshape(b, l, n, w // n).transpose(0, 2, 1, 3)


def merge_heads(t):
    b, h, l, d = t.shape
    return t.transpose(0, 2, 1, 3).reshape(b, l, h * d)


def retention_scan(q, k, v, log_gamma, strict):
    b, h, lp, dk = q.shape
    dv = v.shape[-1]
    c = RET_CHUNK
    nc = lp // c
    qc = q.reshape(b, h, nc, c, dk)
    kc = k.reshape(b, h, nc, c, dk)
    vc = v.reshape(b, h, nc, c, dv)
    idx = jnp.arange(c, dtype=f32)
    diff = idx[:, None] - idx[None, :]
    keep = (diff > 0) if strict else (diff >= 0)
    lg = log_gamma[:, None, None]
    dmat = jnp.where(keep[None], jnp.exp(jnp.where(keep, diff, 0.0)[None] * lg), 0.0)
    s = jnp.einsum('bhncd,bhnsd->bhncs', qc, kc) * dmat[None, :, None].astype(q.dtype)
    o_intra = jnp.einsum('bhncs,bhnse->bhnce', s, vc)
    k_dec = jnp.exp((c - 1 - idx)[None, :] * log_gamma[:, None]).astype(q.dtype)
    kv = jnp.einsum('bhncd,bhnce->nbhde', kc * k_dec[None, :, None, :, None], vc).astype(f32)
    chunk_dec = jnp.exp(c * log_gamma)[None, :, None, None]

    def step(state, kv_n):
        return state * chunk_dec + kv_n, state

    _, prev = lax.scan(step, jnp.zeros((b, h, dk, dv), f32), kv)
    q_dec = jnp.exp((idx + 1)[None, :] * log_gamma[:, None]).astype(q.dtype)
    o_inter = jnp.einsum('bhncd,nbhde->bhnce', qc * q_dec[None, :, None, :, None], prev.astype(q.dtype))
    return (o_intra + o_inter).reshape(b, h, lp, dv)


def retention_branch(q, k, v, g, pos, log2_dec_f, log2_dec_b, out_gain):
    q = rope(to_heads(q, RET_HEADS), pos)
    k = rope(to_heads(k, RET_HEADS), pos) * (RET_DK ** -0.5)
    v = to_heads(v, RET_HEADS)
    L = q.shape[2]
    P = (-L) % RET_CHUNK
    lg_f = jnp.log1p(-jnp.exp2(-log2_dec_f.astype(f32)))
    lg_b = jnp.log1p(-jnp.exp2(-log2_dec_b.astype(f32)))
    pad_front = lambda t: jnp.pad(t, ((0, 0), (0, 0), (P, 0), (0, 0)))
    pad_back = lambda t: jnp.pad(t, ((0, 0), (0, 0), (0, P), (0, 0)))
    flip = lambda t: jnp.flip(t, axis=2)
    o_f = retention_scan(pad_front(q), pad_front(k), pad_front(v), lg_f, False)[:, :, P:]
    o_b = flip(retention_scan(pad_back(flip(q)), pad_back(flip(k)), pad_back(flip(v)), lg_b, True)[:, :, :L])
    o = rms_norm(o_f + o_b, out_gain.reshape(RET_HEADS, 1, RET_DV))
    return merge_heads(o) * jax.nn.silu(g)


def diff_branch(q, k, v, pos, q_gain, k_gain, lam_vecs, out_gain, lambda_init):
    b, L, _ = q.shape
    q = q.reshape(b, L, DIFF_HEADS, 2, DIFF_DH).transpose(0, 2, 3, 1, 4)
    k = k.reshape(b, L, DIFF_HEADS, 2, DIFF_DH).transpose(0, 2, 3, 1, 4)
    v = to_heads(v, DIFF_HEADS)
    q = rope(rms_norm(q, q_gain), pos)
    k = rope(rms_norm(k, k_gain), pos)
    lv = lam_vecs.astype(f32)
    lam = jnp.exp(jnp.sum(lv[0] * lv[1])) - jnp.exp(jnp.sum(lv[2] * lv[3])) + lambda_init
    scale = DIFF_DH ** -0.5
    P = (-L) % Q_BLOCK
    nb = (L + P) // Q_BLOCK
    qp = jnp.pad(q, ((0, 0), (0, 0), (0, 0), (0, P), (0, 0)))
    qb = qp.reshape(b, DIFF_HEADS, 2, nb, Q_BLOCK, DIFF_DH).transpose(3, 0, 1, 2, 4, 5)

    def block(qblk):
        s = jnp.einsum('bhiqd,bhikd->bhiqk', qblk, k).astype(f32) * scale
        p = jax.nn.softmax(s, axis=-1)
        a = p[:, :, 0] - lam * p[:, :, 1]
        return jnp.einsum('bhqk,bhke->bhqe', a.astype(v.dtype), v)

    o = lax.map(block, qb)
    o = o.transpose(1, 2, 0, 3, 4).reshape(b, DIFF_HEADS, nb * Q_BLOCK, DIFF_DV)[:, :, :L]
    o = rms_norm(o, out_gain) * (1.0 - lambda_init)
    return merge_heads(o)


def na_branch(q, k, v, q_gain, k_gain, rpb):
    q = rms_norm(to_heads(q, NA_HEADS), q_gain)
    k = rms_norm(to_heads(k, NA_HEADS), k_gain)
    v = to_heads(v, NA_HEADS)
    b, h, L, d = q.shape
    scale = NA_DH ** -0.5
    qm, qr = q[:, :, :N_META], q[:, :, N_META:]
    km, kr = k[:, :, :N_META], k[:, :, N_META:]
    vm, vr = v[:, :, :N_META], v[:, :, N_META:]
    S = qr.shape[2]
    rows = S // GRID_W
    wr = min(NA_WIN_R, rows)
    pm = jax.nn.softmax(jnp.einsum('bhqd,bhkd->bhqk', qm, km).astype(f32) * scale, axis=-1)
    om = jnp.einsum('bhqk,bhkd->bhqd', pm.astype(v.dtype), vm)
    qg = qr.reshape(b, h, rows, GRID_W, d)
    kg = kr.reshape(b, h, rows, GRID_W, d)
    vg = vr.reshape(b, h, rows, GRID_W, d)
    col = jnp.arange(GRID_W)
    cstart = jnp.clip(col - NA_WIN_C // 2, 0, GRID_W - NA_WIN_C)
    col_ok = (col[None, :] >= cstart[:, None]) & (col[None, :] < cstart[:, None] + NA_WIN_C)
    dc_idx = jnp.clip(col[None, :] - col[:, None] + NA_WIN_C - 1, 0, 2 * NA_WIN_C - 2)
    rpb_c = rpb.astype(f32)[:, :, dc_idx]
    bias_c = jnp.where(col_ok[None, None], rpb_c, -1e30)

    def row_block(r):
        rs = jnp.clip(r - wr // 2, 0, rows - wr)
        q_r = lax.dynamic_index_in_dim(qg, r, axis=2, keepdims=False)
        k_b = lax.dynamic_slice_in_dim(kg, rs, wr, axis=2)
        v_b = lax.dynamic_slice_in_dim(vg, rs, wr, axis=2)
        dr_idx = rs + jnp.arange(wr) - r + NA_WIN_R - 1
        bias = jnp.take(bias_c, dr_idx, axis=1).transpose(0, 2, 1, 3)
        s_win = jnp.einsum('bhqd,bhrkd->bhqrk', q_r, k_b).astype(f32) * scale + bias[None]
        s_win = s_win.reshape(b, h, GRID_W, wr * GRID_W)
        s_meta = jnp.einsum('bhqd,bhmd->bhqm', q_r, km).astype(f32) * scale
        p = jax.nn.softmax(jnp.concatenate([s_win, s_meta], axis=-1), axis=-1).astype(v.dtype)
        nw = wr * GRID_W
        return (jnp.einsum('bhqk,bhkd->bhqd', p[..., :nw], v_b.reshape(b, h, nw, d))
                + jnp.einsum('bhqm,bhmd->bhqd', p[..., nw:], vm))

    o_rows = lax.map(row_block, jnp.arange(rows))
    o_real = o_rows.transpose(1, 2, 0, 3, 4).reshape(b, h, S, d)
    return merge_heads(jnp.concatenate([om, o_real], axis=2))


def conv_ffn(h, w_up, conv_w, conv_b, w_down):
    u = h @ w_up
    gate, val = u[..., :D_FF], u[..., D_FF:]
    gp = jnp.pad(gate, ((0, 0), (1, 1), (0, 0)))
    gate = gp[:, :-2] * conv_w[0] + gp[:, 1:-1] * conv_w[1] + gp[:, 2:] * conv_w[2] + conv_b
    return (jax.nn.silu(gate) * val) @ w_down


def setup_inputs(seed: int = 0) -> dict:
    key = jax.random.key(seed)
    ks = jax.random.split(key, 24)
    n = lambda k, shape, s: jax.random.normal(k, shape, f32) * s
    gain = lambda k, shape: 1.0 + 0.02 * jax.random.normal(k, shape, f32)
    base_dec = 5.0 + jnp.arange(RET_HEADS, dtype=f32)
    return {
        "x": n(ks[0], (BATCH, SEQ, D_MODEL), 1.0),
        "meta_tokens": n(ks[1], (N_META, D_MODEL), 1.0),
        "norm_mix": gain(ks[2], (DEPTH, D_MODEL)),
        "w_in": n(ks[3], (DEPTH, D_MODEL, IN_WIDTH), D_MODEL ** -0.5),
        "ret_log2_decay_f": base_dec[None] + 0.1 * jax.random.normal(ks[4], (DEPTH, RET_HEADS), f32),
        "ret_log2_decay_b": base_dec[None] + 0.1 * jax.random.normal(ks[5], (DEPTH, RET_HEADS), f32),
        "ret_out_gain": gain(ks[6], (DEPTH, RET_OUT_W)),
        "diff_q_gain": gain(ks[7], (DEPTH, DIFF_DH)),
        "diff_k_gain": gain(ks[8], (DEPTH, DIFF_DH)),
        "diff_lambda": n(ks[9], (DEPTH, 4, DIFF_DH), 0.1),
        "diff_out_gain": gain(ks[10], (DEPTH, DIFF_DV)),
        "na_q_gain": gain(ks[11], (DEPTH, NA_DH)),
        "na_k_gain": gain(ks[12], (DEPTH, NA_DH)),
        "na_rpb": n(ks[13], (DEPTH, NA_HEADS, 2 * NA_WIN_R - 1, 2 * NA_WIN_C - 1), 0.1),
        "w_br_ret": n(ks[14], (DEPTH, RET_OUT_W, D_MODEL), RET_OUT_W ** -0.5),
        "w_br_diff": n(ks[15], (DEPTH, DIFF_OUT_W, D_MODEL), DIFF_OUT_W ** -0.5),
        "w_br_na": n(ks[16], (DEPTH, NA_OUT_W, D_MODEL), NA_OUT_W ** -0.5),
        "w_out": n(ks[17], (DEPTH, D_MODEL, D_MODEL), D_MODEL ** -0.5),
        "norm_ffn": gain(ks[18], (DEPTH, D_MODEL)),
        "w_up": n(ks[19], (DEPTH, D_MODEL, 2 * D_FF), D_MODEL ** -0.5),
        "ffn_conv_w": n(ks[20], (DEPTH, CONV_W, D_FF), CONV_W ** -0.5),
        "ffn_conv_b": n(ks[21], (DEPTH, D_FF), 0.02),
        "w_down": n(ks[22], (DEPTH, D_FF, D_MODEL), D_FF ** -0.5),
    }


def reference(x, meta_tokens, norm_mix, w_in, ret_log2_decay_f, ret_log2_decay_b, ret_out_gain,
              diff_q_gain, diff_k_gain, diff_lambda, diff_out_gain, na_q_gain, na_k_gain, na_rpb,
              w_br_ret, w_br_diff, w_br_na, w_out, norm_ffn, w_up, ffn_conv_w, ffn_conv_b, w_down):
    b = x.shape[0]
    meta = jnp.broadcast_to(meta_tokens[None].astype(x.dtype), (b, N_META, x.shape[-1]))
    h = jnp.concatenate([meta, x], axis=1)
    L = h.shape[1]
    pos = jnp.arange(L)
    split_pts = np.cumsum(IN_SIZES)[:-1].tolist()
    for l in range(DEPTH):
        lambda_init = 0.8 - 0.6 * math.exp(-0.3 * l)
        u = rms_norm(h, norm_mix[l])
        (rq, rk, rv, rg, dq, dk, dv, nq, nk, nv, gates) = jnp.split(u @ w_in[l], split_pts, axis=-1)
        y_ret = retention_branch(rq, rk, rv, rg, pos, ret_log2_decay_f[l], ret_log2_decay_b[l], ret_out_gain[l])
        y_diff = diff_branch(dq, dk, dv, pos, diff_q_gain[l], diff_k_gain[l], diff_lambda[l],
                             diff_out_gain[l], lambda_init)
        y_na = na_branch(nq, nk, nv, na_q_gain[l], na_k_gain[l], na_rpb[l])
        g_ret, g_diff, g_na = jnp.split(jax.nn.sigmoid(gates), 3, axis=-1)
        merged = (g_ret * (y_ret @ w_br_ret[l]) + g_diff * (y_diff @ w_br_diff[l])
                  + g_na * (y_na @ w_br_na[l]))
        h = h + merged @ w_out[l]
        h = h + conv_ffn(rms_norm(h, norm_ffn[l]), w_up[l], ffn_conv_w[l], ffn_conv_b[l], w_down[l])
    return h[:, N_META:]
```

```cpp
#include <hip/hip_runtime.h>
#include <hip/hip_cooperative_groups.h>
#include <cstdio>
#include <cstdint>
namespace cg = cooperative_groups;

#define LAS __attribute__((address_space(3)))
typedef unsigned short bf16_t;
typedef short bf16x8 __attribute__((ext_vector_type(8)));
typedef short bf16x4 __attribute__((ext_vector_type(4)));
typedef float f32x4 __attribute__((ext_vector_type(4)));
typedef unsigned u32x4 __attribute__((ext_vector_type(4)));
typedef unsigned u32x2 __attribute__((ext_vector_type(2)));

constexpr int D = 2048, NBATCH = 16, SEQ = 2048, NMETA = 16, LTOK = 2064;
constexpr int M = 33024;
constexpr int RB = 256;
constexpr int NPROJ = 6144;
constexpr int PP = 2048;
constexpr size_t PBUF = (size_t)M * PP;
constexpr int NVT = 3072;
constexpr int NIN = 15360, DFF = 5504;
constexpr int C_RQ = 0, C_RK = 512, C_RG = 1024, C_DQ = 2048, C_DK = 3072, C_NQ = 4096, C_NK = 5120;
constexpr int V_RET = 0, V_DIFF = 1024, V_NA = 2048;
constexpr float EPS = 1e-6f;
constexpr float LOG2E = 1.4426950408889634f;

constexpr size_t WS_CTL = 0;
constexpr size_t CTL_BYTES = 32768;
constexpr size_t WS_MISC = 32768;
constexpr size_t WS_ROPE64 = 65536;
constexpr size_t WS_ROPE128 = WS_ROPE64 + (size_t)LTOK * 32 * 8;
constexpr size_t WS_HMETA = 2u << 20;
constexpr size_t WS_WT = 8u << 20;
constexpr size_t WT_IN = 0;
constexpr size_t WT_BR = WT_IN + (size_t)NIN * D * 2;
constexpr size_t WT_OUT = WT_BR + (size_t)3 * D * 2048 * 2;
constexpr size_t WT_UP = WT_OUT + (size_t)D * D * 2;
constexpr size_t WT_DOWN = WT_UP + (size_t)2 * DFF * D * 2;
constexpr size_t WT_BYTES = WT_DOWN + (size_t)D * DFF * 2;
constexpr size_t WS_U = WS_WT + WT_BYTES;
constexpr size_t WS_BIG = WS_U + (size_t)M * D * 2;
constexpr size_t BIG_PROJ = 0;
constexpr size_t BIG_VT = (size_t)M * NPROJ * 2;
constexpr size_t BIG_MERGED = BIG_VT;
constexpr size_t BIG_GATE = BIG_MERGED + (size_t)M * D * 2;
constexpr size_t BIG_G = 0;
constexpr size_t BIG_V = (size_t)M * DFF * 2;
constexpr size_t BIG_BYTES = (size_t)2 * M * DFF * 2;
constexpr size_t WS_END = WS_BIG + BIG_BYTES;
static_assert(BIG_GATE + (size_t)M * D * 2 <= BIG_BYTES, "merged + gate buffers fit behind PROJ");
static_assert(BIG_VT + (size_t)NVT * M * 2 <= BIG_BYTES, "mixer buffers fit");
static_assert(WS_ROPE128 + (size_t)LTOK * 64 * 8 <= WS_HMETA, "rope tables");

struct Params {
    const float* in[23];
    float* out;
    unsigned char* ws;
};
typedef const Params __attribute__((address_space(4)))* ParamsCP;
__device__ __forceinline__ ParamsCP get_params() { ParamsCP q = (ParamsCP)__builtin_amdgcn_kernarg_segment_ptr(); asm volatile("" : "+s"(q)); return q; }

__device__ __forceinline__ float bf2f(unsigned short b) { return __uint_as_float(((unsigned)b) << 16); }
typedef __bf16 bf16x2_t __attribute__((ext_vector_type(2)));
typedef float f32x2_t __attribute__((ext_vector_type(2)));
__device__ __forceinline__ unsigned pk2(float lo, float hi) { f32x2_t v = {lo, hi}; bf16x2_t b = __builtin_convertvector(v, bf16x2_t); return __builtin_bit_cast(unsigned, b); }
__device__ __forceinline__ unsigned f2bf(float f) { return pk2(f, 0.f) & 0xffffu; }
__device__ __forceinline__ float lo_f(unsigned w) { return __uint_as_float(w << 16); }
__device__ __forceinline__ float hi_f(unsigned w) { return __uint_as_float(w & 0xffff0000u); }
__device__ __forceinline__ unsigned cvt_pk_bf16(float lo, float hi) { return pk2(lo, hi); }
__device__ __forceinline__ float wave_sum(float v) {
#pragma unroll
    for (int o = 1; o < 64; o <<= 1) v += __shfl_xor(v, o);
    return v;
}
__device__ __forceinline__ float wave_max(float v) {
#pragma unroll
    for (int o = 1; o < 64; o <<= 1) v = fmaxf(v, __shfl_xor(v, o));
    return v;
}
__device__ __forceinline__ float fast_exp2(float x) { return __builtin_amdgcn_exp2f(x); }
__device__ __forceinline__ float fast_rcp(float x) { return __builtin_amdgcn_rcpf(x); }
__device__ __forceinline__ f32x4 mfma16(bf16x8 a, bf16x8 b, f32x4 c) { return __builtin_amdgcn_mfma_f32_16x16x32_bf16(a, b, c, 0, 0, 0); }
template <class T> __device__ __forceinline__ T* uniform_ptr(T* p) {
    const unsigned long long v = (unsigned long long)p;
    const unsigned lo = (unsigned)__builtin_amdgcn_readfirstlane((int)(unsigned)v), hi = (unsigned)__builtin_amdgcn_readfirstlane((int)(unsigned)(v >> 32));
    return (T*)(((unsigned long long)hi << 32) | lo);
}
__device__ __forceinline__ int tile_row(int b, int j) { return j == 0 ? b * 16 : (RB - 16) + b * SEQ + 16 * j; }

namespace pg8 {
constexpr int BM = 256, BK = 64, HALF = 128, HTB = HALF * BK * 2, STAGE_BYTES = 8 * HTB, NXCD = 8, WGM = 8;
__device__ __forceinline__ int lds_byte(int r, int c) { const int st = (r >> 4) * 2 + (c >> 5), rr = r & 15, cc = c & 31, ob = rr * 64 + cc * 2; return st * 1024 + (ob ^ (((ob >> 9) & 1) << 5)); }
__device__ __forceinline__ void stage_rc(int b, int& R, int& C) { const int st = b / 1024, sb = b % 1024, swz = sb ^ (((sb >> 9) & 1) << 5); R = (st >> 1) * 16 + swz / 64; C = (st & 1) * 32 + (swz % 64) / 2; }
__device__ __forceinline__ int perm32(int rho) { const int n = rho >> 4, i = rho & 15; return 8 * (i >> 2) + 4 * n + (i & 3); }

struct GUnit { const char* A; const char* B; unsigned lda, ldb; int nt, kind, pm, pn; };

__device__ __forceinline__ void tile_map(int L, int nM, int nN, int& pm, int& pn) {
    const int nwg = nM * nN; int wgid = L;
    { const int q = nwg / NXCD, r = nwg % NXCD, xcd = wgid % NXCD, off = wgid / NXCD; wgid = (xcd < r ? xcd * (q + 1) : r * (q + 1) + (xcd - r) * q) + off; }
    const int nig = WGM * nN, gid = wgid / nig, fm = gid * WGM, gsz = (nM - fm) < WGM ? (nM - fm) : WGM;
    pm = fm + ((wgid % nig) % gsz); pn = (wgid % nig) / gsz;
}

template <class Epi, class Sched>
__device__ __forceinline__ void gemm_phase(LAS unsigned char* lds, const Sched& S, const Epi& E, const int tid) {
    const int wid = __builtin_amdgcn_readfirstlane(tid >> 6), lane = tid & 63, wr = wid >> 2, wc = wid & 3, fr = lane & 15, fq = lane >> 4;
    int sR[2], sC[2], sRbi[2];
#pragma unroll
    for (int i = 0; i < 2; ++i) { stage_rc(tid * 16 + i * 8192, sR[i], sC[i]); sRbi[i] = (sR[i] & ~31) + perm32(sR[i] & 31); }
    const unsigned ldsw = (unsigned)wid * 1024u;
    const int aoff = lds_byte(wr * 64 + fr, fq * 8), boff = lds_byte(wc * 32 + fr, fq * 8);
#define PG8_SA(b, h) (((b) * 2 + (h)) * HTB)
#define PG8_SB(b, h) ((4 + (b) * 2 + (h)) * HTB)
#define PG8_STAGE(bufoff, gbase, rows) do { _Pragma("unroll") for (int _i = 0; _i < 2; ++_i) \
        __builtin_amdgcn_global_load_lds((const unsigned*)((const char*)(gbase) + (rows)[_i]), (LAS unsigned*)(lds + (bufoff) + ldsw + _i * 8192), 16, 0, 0); } while (0)
#define PG8_LDA(dst, b, h) do { _Pragma("unroll") for (int m = 0; m < 4; ++m) _Pragma("unroll") for (int k = 0; k < 2; ++k) dst[m][k] = *(const LAS bf16x8*)(lds + PG8_SA(b, h) + aoff + m * 2048 + k * 1024); } while (0)
#define PG8_LDB(dst, b, h) do { _Pragma("unroll") for (int n = 0; n < 2; ++n) _Pragma("unroll") for (int k = 0; k < 2; ++k) dst[n][k] = *(const LAS bf16x8*)(lds + PG8_SB(b, h) + boff + n * 2048 + k * 1024); } while (0)
#define PG8_MMA(ai, bj, At, Bt) do { __builtin_amdgcn_s_setprio(1); _Pragma("unroll") for (int m = 0; m < 4; ++m) _Pragma("unroll") for (int n = 0; n < 2; ++n) _Pragma("unroll") for (int k = 0; k < 2; ++k) \
        acc[ai][bj][m][n] = __builtin_amdgcn_mfma_f32_16x16x32_bf16(Bt[n][k], At[m][k], acc[ai][bj][m][n], 0, 0, 0); __builtin_amdgcn_s_setprio(0); } while (0)
#define PG8_WAIT_V(n) asm volatile("s_waitcnt vmcnt(" #n ")" ::: "memory")
#define PG8_WAIT_L(n) asm volatile("s_waitcnt lgkmcnt(" #n ")" ::: "memory")
#define PG8_BAR __builtin_amdgcn_s_barrier()
#define PG8_SCHED __builtin_amdgcn_sched_barrier(0)
    GUnit cur, nxt; int ui = 0;
    if (!S.next(0, cur)) return;
    f32x4 acc[2][2][4][2];
#pragma unroll
    for (int a = 0; a < 2; ++a)
#pragma unroll
        for (int b = 0; b < 2; ++b)
#pragma unroll
            for (int m = 0; m < 4; ++m)
#pragma unroll
                for (int n = 0; n < 2; ++n) acc[a][b][m][n] = (f32x4){0.f, 0.f, 0.f, 0.f};
    bf16x8 At[4][2], B0[2][2], B1[2][2];
    const char* cA = cur.A; const char* cB = cur.B;
    constexpr unsigned kstep = (unsigned)(BK * 2);
    const unsigned lda = cur.lda, ldb = cur.ldb, hA = HALF * lda, hB = HALF * ldb;
    unsigned vA[2], vB[2];
#pragma unroll
    for (int i = 0; i < 2; ++i) { vA[i] = (unsigned)sR[i] * lda + (unsigned)sC[i] * 2u; vB[i] = (unsigned)sRbi[i] * ldb + (unsigned)sC[i] * 2u; }
    PG8_STAGE(PG8_SB(0, 0), cB, vB); PG8_STAGE(PG8_SB(0, 1), cB + hB, vB); PG8_STAGE(PG8_SA(0, 0), cA, vA); PG8_STAGE(PG8_SA(0, 1), cA + hA, vA);
    if (wr == 1) PG8_BAR;
    PG8_WAIT_V(2); PG8_BAR;
    PG8_STAGE(PG8_SB(1, 0), cB + kstep, vB); PG8_STAGE(PG8_SA(1, 0), cA + kstep, vA); PG8_STAGE(PG8_SB(1, 1), cB + hB + kstep, vB);
    PG8_WAIT_V(6); PG8_BAR;
    for (;;) {
        const bool has_next = S.next(ui + 1, nxt);
        const char* nA = has_next ? nxt.A : cA; const char* nB = has_next ? nxt.B : cB;
        const int nt = cur.nt;
        for (int t = 0; t < nt; t += 2) {
            const bool last = (t == nt - 2);
            const char* a1 = cA + (size_t)(t + 1) * kstep;
            const char* a2 = last ? nA : cA + (size_t)(t + 2) * kstep; const char* b2 = last ? nB : cB + (size_t)(t + 2) * kstep;
            const char* a3 = a2 + kstep; const char* b3 = b2 + kstep;
            PG8_LDB(B0, 0, 0); PG8_LDB(B1, 0, 1); PG8_SCHED; PG8_LDA(At, 0, 0); PG8_STAGE(PG8_SA(1, 1), a1 + hA, vA);
            PG8_WAIT_V(8); PG8_WAIT_L(0); PG8_BAR; PG8_MMA(0, 0, At, B0); PG8_MMA(0, 1, At, B1); PG8_BAR; PG8_SCHED;
            PG8_LDA(At, 0, 1); PG8_STAGE(PG8_SB(0, 0), b2, vB); PG8_STAGE(PG8_SB(0, 1), b2 + hB, vB); PG8_STAGE(PG8_SA(0, 0), a2, vA);
            PG8_WAIT_V(8); PG8_WAIT_L(0); PG8_BAR; PG8_MMA(1, 0, At, B0); PG8_MMA(1, 1, At, B1); PG8_BAR; PG8_SCHED;
            PG8_LDB(B0, 1, 0); PG8_LDB(B1, 1, 1); PG8_SCHED; PG8_LDA(At, 1, 0); PG8_STAGE(PG8_SA(0, 1), a2 + hA, vA);
            PG8_WAIT_V(8); PG8_WAIT_L(0); PG8_BAR; PG8_MMA(0, 0, At, B0); PG8_MMA(0, 1, At, B1); PG8_BAR; PG8_SCHED;
            PG8_LDA(At, 1, 1); PG8_STAGE(PG8_SB(1, 0), b3, vB); PG8_STAGE(PG8_SB(1, 1), b3 + hB, vB); PG8_STAGE(PG8_SA(1, 0), a3, vA);
            PG8_WAIT_V(8); PG8_WAIT_L(0); PG8_BAR; PG8_MMA(1, 0, At, B0); PG8_MMA(1, 1, At, B1); PG8_BAR; PG8_SCHED;
        }
        if (wr == 0) PG8_BAR;
        E(acc, cur);
        if (!has_next) break;
#pragma unroll
        for (int a = 0; a < 2; ++a)
#pragma unroll
            for (int b = 0; b < 2; ++b)
#pragma unroll
                for (int m = 0; m < 4; ++m)
#pragma unroll
                    for (int n = 0; n < 2; ++n) acc[a][b][m][n] = (f32x4){0.f, 0.f, 0.f, 0.f};
        cur = nxt; cA = nA; cB = nB; ++ui;
        if (wr == 1) PG8_BAR;
    }
    PG8_WAIT_V(0);
    PG8_BAR;
#undef PG8_SA
#undef PG8_SB
#undef PG8_STAGE
#undef PG8_LDA
#undef PG8_LDB
#undef PG8_MMA
#undef PG8_WAIT_V
#undef PG8_WAIT_L
#undef PG8_BAR
#undef PG8_SCHED
}
}
using pg8::GUnit;

struct SchedIn {
    const char* U; const char* WT; int G, c;
    __device__ __forceinline__ bool next(int i, GUnit& u) const {
        const int L = i * G + c; int pm, pn;
        if (L < 3096) { pg8::tile_map(L, 129, 24, pm, pn); u.A = U + (size_t)pm * 256 * 4096; u.B = WT + (size_t)pn * 256 * 4096; u.kind = 0; }
        else if (L < 3096 + 1548) { pg8::tile_map(L - 3096, 12, 129, pm, pn); u.A = WT + (size_t)(NPROJ + pm * 256) * 4096; u.B = U + (size_t)pn * 256 * 4096; u.kind = 1; }
        else return false;
        u.pm = pm; u.pn = pn; u.lda = 4096; u.ldb = 4096; u.nt = 32; return true;
    }
};
struct SchedPlain {
    const char* A; const char* B; unsigned lda, ldb; int nt, nM, nN, pm0, G, c;
    __device__ __forceinline__ bool next(int i, GUnit& u) const {
        const int L = i * G + c; if (L >= nM * nN) return false;
        int pm, pn; pg8::tile_map(L, nM, nN, pm, pn); pm += pm0;
        u.pm = pm; u.pn = pn; u.kind = 0; u.A = A + (size_t)pm * 256 * lda; u.B = B + (size_t)pn * 256 * ldb; u.lda = lda; u.ldb = ldb; u.nt = nt; return true;
    }
};

struct LaneId { int wr, wc, fr, fq; };
__device__ __forceinline__ LaneId lane_id_fresh() { int t = threadIdx.x; asm volatile("" : "+v"(t)); LaneId r; r.wr = t >> 8; r.wc = (t >> 6) & 3; r.fr = t & 15; r.fq = (t >> 4) & 3; return r; }
struct EpiIn {
    bf16_t* PROJ; bf16_t* VT;
    __device__ __forceinline__ void operator()(const f32x4 (&acc)[2][2][4][2], const GUnit& u) const {
        const LaneId L_ = lane_id_fresh(); const int wr = L_.wr, wc = L_.wc, fr = L_.fr, fq = L_.fq;
        char* base; unsigned ldb2;
        if (u.kind == 0) { base = (char*)(PROJ + (size_t)(u.pn >> 3) * PBUF + (size_t)u.pm * 256 * PP + (size_t)(u.pn & 7) * 256); ldb2 = PP * 2; }
        else { base = (char*)(VT + (size_t)u.pm * 256 * M + (size_t)u.pn * 256); ldb2 = M * 2; }
        base = uniform_ptr(base);
        const unsigned lo = (unsigned)(wr * 64 + fr) * ldb2 + (unsigned)(wc * 32 + 8 * fq) * 2u;
#pragma unroll
        for (int ai = 0; ai < 2; ++ai)
#pragma unroll
            for (int m = 0; m < 4; ++m) { const unsigned ro = lo + (unsigned)(ai * 128 + m * 16) * ldb2;
#pragma unroll
                for (int bj = 0; bj < 2; ++bj) { const f32x4 v0 = acc[ai][bj][m][0], v1 = acc[ai][bj][m][1];
                    u32x4 w; w.x = cvt_pk_bf16(v0[0], v0[1]); w.y = cvt_pk_bf16(v0[2], v0[3]); w.z = cvt_pk_bf16(v1[0], v1[1]); w.w = cvt_pk_bf16(v1[2], v1[3]);
                    *(u32x4*)(base + (ro + bj * 256u)) = w; } }
    }
};
__device__ __forceinline__ float sigmoid_f(float x) { return fast_rcp(1.0f + fast_exp2(-x * LOG2E)); }
struct EpiGate {
    bf16_t* GATE;
    __device__ __forceinline__ void operator()(const f32x4 (&acc)[2][2][4][2], const GUnit& u) const {
        const LaneId L_ = lane_id_fresh(); const int wr = L_.wr, wc = L_.wc, fr = L_.fr, fq = L_.fq;
        char* gb = uniform_ptr((char*)(GATE + (size_t)u.pm * 256 * D + (size_t)u.pn * 256));
        const unsigned lo = (unsigned)(wr * 64 + fr) * (D * 2u) + (unsigned)(wc * 32 + 8 * fq) * 2u;
#pragma unroll
        for (int ai = 0; ai < 2; ++ai)
#pragma unroll
            for (int m = 0; m < 4; ++m)
#pragma unroll
                for (int bj = 0; bj < 2; ++bj) { const f32x4 v0 = acc[ai][bj][m][0], v1 = acc[ai][bj][m][1];
                    u32x4 w; w.x = cvt_pk_bf16(sigmoid_f(v0[0]), sigmoid_f(v0[1])); w.y = cvt_pk_bf16(sigmoid_f(v0[2]), sigmoid_f(v0[3]));
                    w.z = cvt_pk_bf16(sigmoid_f(v1[0]), sigmoid_f(v1[1])); w.w = cvt_pk_bf16(sigmoid_f(v1[2]), sigmoid_f(v1[3]));
                    *(u32x4*)(gb + (lo + (unsigned)(ai * 128 + m * 16) * (D * 2u) + bj * 256u)) = w; }
    }
};
struct EpiYM {
    const bf16_t* GATE; bf16_t* MERGED; int first;
    __device__ __forceinline__ void operator()(const f32x4 (&acc)[2][2][4][2], const GUnit& u) const {
        const LaneId L_ = lane_id_fresh(); const int wr = L_.wr, wc = L_.wc, fr = L_.fr, fq = L_.fq;
        const size_t tb = (size_t)u.pm * 256 * D + (size_t)u.pn * 256;
        const char* gb = uniform_ptr((const char*)(GATE + tb)); char* mgb = uniform_ptr((char*)(MERGED + tb));
        const unsigned lo = (unsigned)(wr * 64 + fr) * (D * 2u) + (unsigned)(wc * 32 + 8 * fq) * 2u;
#pragma unroll
        for (int ai = 0; ai < 2; ++ai) {
            u32x4 gq[4][2], pq[4][2];
#pragma unroll
            for (int m = 0; m < 4; ++m)
#pragma unroll
                for (int bj = 0; bj < 2; ++bj) { const unsigned o = lo + (unsigned)(ai * 128 + m * 16) * (D * 2u) + bj * 256u;
                    gq[m][bj] = *(const u32x4*)(gb + o); pq[m][bj] = first ? (u32x4){0u, 0u, 0u, 0u} : *(const u32x4*)(mgb + o); }
#pragma unroll
            for (int m = 0; m < 4; ++m)
#pragma unroll
                for (int bj = 0; bj < 2; ++bj) { const f32x4 v0 = acc[ai][bj][m][0], v1 = acc[ai][bj][m][1];
                    const unsigned o = lo + (unsigned)(ai * 128 + m * 16) * (D * 2u) + bj * 256u;
                    const u32x4 g = gq[m][bj], p = pq[m][bj];
                    float r[8];
                    r[0] = v0[0] * lo_f(g.x) + lo_f(p.x); r[1] = v0[1] * hi_f(g.x) + hi_f(p.x); r[2] = v0[2] * lo_f(g.y) + lo_f(p.y); r[3] = v0[3] * hi_f(g.y) + hi_f(p.y);
                    r[4] = v1[0] * lo_f(g.z) + lo_f(p.z); r[5] = v1[1] * hi_f(g.z) + hi_f(p.z); r[6] = v1[2] * lo_f(g.w) + lo_f(p.w); r[7] = v1[3] * hi_f(g.w) + hi_f(p.w);
                    u32x4 w; w.x = cvt_pk_bf16(r[0], r[1]); w.y = cvt_pk_bf16(r[2], r[3]); w.z = cvt_pk_bf16(r[4], r[5]); w.w = cvt_pk_bf16(r[6], r[7]);
                    *(u32x4*)(mgb + o) = w; }
            asm volatile("" ::: "memory");
        }
    }
};
struct EpiResid {
    const float* in_real; const float* in_meta; float* out_real; float* out_meta;
    __device__ __forceinline__ void operator()(const f32x4 (&acc)[2][2][4][2], const GUnit& u) const {
        const LaneId L_ = lane_id_fresh(); const int wr = L_.wr, wc = L_.wc, fr = L_.fr, fq = L_.fq;
        const char* ip; char* op;
        if (u.pm == 0) { ip = (const char*)(in_meta + u.pn * 256); op = (char*)(out_meta + u.pn * 256); }
        else { ip = (const char*)(in_real + (size_t)(u.pm - 1) * 256 * D + u.pn * 256); op = (char*)(out_real + (size_t)(u.pm - 1) * 256 * D + u.pn * 256); }
        ip = uniform_ptr(ip); op = uniform_ptr(op);
        const unsigned lo = (unsigned)(wr * 64 + fr) * (D * 4u) + (unsigned)(wc * 32 + 8 * fq) * 4u;
#pragma unroll
        for (int ai = 0; ai < 2; ++ai) {
            f32x4 ra[4][2], rb[4][2];
#pragma unroll
            for (int m = 0; m < 4; ++m)
#pragma unroll
                for (int bj = 0; bj < 2; ++bj) { const unsigned o = lo + (unsigned)(ai * 128 + m * 16) * (D * 4u) + bj * 512u; ra[m][bj] = *(const f32x4*)(ip + o); rb[m][bj] = *(const f32x4*)(ip + (o + 16u)); }
#pragma unroll
            for (int m = 0; m < 4; ++m)
#pragma unroll
                for (int bj = 0; bj < 2; ++bj) { const unsigned o = lo + (unsigned)(ai * 128 + m * 16) * (D * 4u) + bj * 512u;
                    *(f32x4*)(op + o) = ra[m][bj] + acc[ai][bj][m][0]; *(f32x4*)(op + (o + 16u)) = rb[m][bj] + acc[ai][bj][m][1]; }
            asm volatile("" ::: "memory");
        }
    }
};
struct EpiUp {
    bf16_t* Gb; bf16_t* Vb;
    __device__ __forceinline__ void operator()(const f32x4 (&acc)[2][2][4][2], const GUnit& u) const {
        const LaneId L_ = lane_id_fresh(); const int wr = L_.wr, wc = L_.wc, fr = L_.fr, fq = L_.fq;
        const size_t tb = (size_t)u.pm * 256 * DFF + (size_t)u.pn * 128;
        char* gb = uniform_ptr((char*)(Gb + tb)); char* vb = uniform_ptr((char*)(Vb + tb));
        const unsigned lo = (unsigned)(wr * 64 + fr) * (DFF * 2u) + (unsigned)(wc * 32 + 8 * fq) * 2u;
#pragma unroll
        for (int ai = 0; ai < 2; ++ai)
#pragma unroll
            for (int m = 0; m < 4; ++m)
#pragma unroll
                for (int bj = 0; bj < 2; ++bj) { const f32x4 v0 = acc[ai][bj][m][0], v1 = acc[ai][bj][m][1];
                    u32x4 w; w.x = cvt_pk_bf16(v0[0], v0[1]); w.y = cvt_pk_bf16(v0[2], v0[3]); w.z = cvt_pk_bf16(v1[0], v1[1]); w.w = cvt_pk_bf16(v1[2], v1[3]);
                    *(u32x4*)((bj == 0 ? gb : vb) + (lo + (unsigned)(ai * 128 + m * 16) * (DFF * 2u))) = w; }
    }
};

__device__ __forceinline__ void transpose_item(const float* W, int K, int N, bf16_t* WT, int pitch, int kb, int n0, int drow0, LAS float* scr, int lane) {
    const int k0 = 64 * kb;
#pragma unroll 8
    for (int i = 0; i < 32; ++i) { const int kk = 2 * i + (lane >> 5); scr[kk * 33 + (lane & 31)] = W[(size_t)(k0 + kk) * N + n0 + (lane & 31)]; }
    asm volatile("s_waitcnt lgkmcnt(0)" ::: "memory");
    const int c = lane & 7;
#pragma unroll
    for (int j = 0; j < 4; ++j) { const int n = (lane >> 3) + 8 * j; const LAS float* s = scr + (8 * c) * 33 + n;
        u32x4 o; o.x = pk2(s[0 * 33], s[1 * 33]); o.y = pk2(s[2 * 33], s[3 * 33]); o.z = pk2(s[4 * 33], s[5 * 33]); o.w = pk2(s[6 * 33], s[7 * 33]);
        *(u32x4*)(WT + (size_t)(drow0 + n) * pitch + k0 + 8 * c) = o; }
    asm volatile("s_waitcnt lgkmcnt(0)" ::: "memory");
}
__device__ __forceinline__ int remap_in(int n) {
    if (n < 1024) return n;
    if (n < 2048) return NPROJ + V_RET + (n - 1024);
    if (n < 3072) return C_RG + (n - 2048);
    if (n < 5120) return C_DQ + (n - 3072);
    if (n < 6144) return NPROJ + V_DIFF + (n - 5120);
    if (n < 8192) return C_NQ + (n - 6144);
    if (n < 9216) return NPROJ + V_NA + (n - 8192);
    return n;
}
__device__ __forceinline__ int remap_up(int n) { return n < DFF ? (n / 128) * 256 + (n % 128) : ((n - DFF) / 128) * 256 + 128 + ((n - DFF) % 128); }

__device__ __forceinline__ void convert_weights(ParamsCP pp, int layer, LAS unsigned char* lds, int gw, int ngw, int wave, int lane) {
    LAS float* scr = (LAS float*)(lds + wave * 16384);
    unsigned char* wt = pp->ws + WS_WT;
    constexpr int I_IN = (D / 64) * (NIN / 32), I_BR = (1024 / 64) * (D / 32), I_OUT = (D / 64) * (D / 32), I_UP = (D / 64) * (2 * DFF / 32), I_DN = (DFF / 64) * (D / 32);
    constexpr int NITEMS = I_IN + 3 * I_BR + I_OUT + I_UP + I_DN;
    for (int it = gw; it < NITEMS; it += ngw) {
        int r = it;
        if (r < I_IN) { const int nblk = NIN / 32, kb = r / nblk, n0 = 32 * (r % nblk);
            transpose_item(pp->in[3] + (size_t)layer * D * NIN, D, NIN, (bf16_t*)(wt + WT_IN), D, kb, n0, remap_in(n0), scr, lane); continue; }
        r -= I_IN;
        if (r < 3 * I_BR) { const int br = r / I_BR; r -= br * I_BR; const int nblk = D / 32, kb = r / nblk, n0 = 32 * (r % nblk);
            transpose_item(pp->in[14 + br] + (size_t)layer * 1024 * D, 1024, D, (bf16_t*)(wt + WT_BR) + (size_t)br * D * 2048, 2048, kb, n0, n0, scr, lane); continue; }
        r -= 3 * I_BR;
        if (r < I_OUT) { const int nblk = D / 32, kb = r / nblk, n0 = 32 * (r % nblk);
            transpose_item(pp->in[17] + (size_t)layer * D * D, D, D, (bf16_t*)(wt + WT_OUT), D, kb, n0, n0, scr, lane); continue; }
        r -= I_OUT;
        if (r < I_UP) { const int nblk = 2 * DFF / 32, kb = r / nblk, n0 = 32 * (r % nblk);
            transpose_item(pp->in[19] + (size_t)layer * D * 2 * DFF, D, 2 * DFF, (bf16_t*)(wt + WT_UP), D, kb, n0, remap_up(n0), scr, lane); continue; }
        r -= I_UP;
        { const int nblk = D / 32, kb = r / nblk, n0 = 32 * (r % nblk);
            transpose_item(pp->in[22] + (size_t)layer * DFF * D, DFF, D, (bf16_t*)(wt + WT_DOWN), DFF, kb, n0, n0, scr, lane); }
    }
}

__device__ __forceinline__ void norm_row(const float* hrow, const float* g, bf16_t* urow, int lane) {
    const f32x4* xr = (const f32x4*)hrow + lane; const f32x4* gr = (const f32x4*)g + lane;
    f32x4 v[8], gg[8]; float s = 0.f;
#pragma unroll
    for (int j = 0; j < 8; ++j) { v[j] = xr[64 * j]; gg[j] = gr[64 * j]; }
#pragma unroll
    for (int j = 0; j < 8; ++j) s += (v[j].x * v[j].x + v[j].y * v[j].y) + (v[j].z * v[j].z + v[j].w * v[j].w);
    const float rstd = rsqrtf(wave_sum(s) * (1.0f / D) + EPS);
    u32x2* o8 = (u32x2*)urow + lane;
#pragma unroll
    for (int j = 0; j < 8; ++j) { u32x2 w; w.x = pk2(v[j].x * rstd * gg[j].x, v[j].y * rstd * gg[j].y); w.y = pk2(v[j].z * rstd * gg[j].z, v[j].w * rstd * gg[j].w); o8[64 * j] = w; }
}
__device__ __forceinline__ void norm_phase(ParamsCP pp, const float* gain, bool layer0_input, int gw, int ngw, int lane) {
    bf16_t* U = (bf16_t*)(pp->ws + WS_U); const float* hmeta = (const float*)(pp->ws + WS_HMETA);
    for (int m = gw; m < M; m += ngw) {
        const float* hrow;
        if (m < RB) hrow = layer0_input ? pp->in[1] + (size_t)(m & 15) * D : hmeta + (size_t)m * D;
        else hrow = (layer0_input ? pp->in[0] : (const float*)pp->out) + (size_t)(m - RB) * D;
        norm_row(hrow, gain, U + (size_t)m * D, lane);
    }
}

__device__ __forceinline__ void setup_phase(ParamsCP pp, int gtid, int ngt, int gw, int lane) {
    float2* r64 = (float2*)(pp->ws + WS_ROPE64); float2* r128 = (float2*)(pp->ws + WS_ROPE128);
    for (int i = gtid; i < LTOK * 32; i += ngt) { const int pos = i >> 5, f = i & 31; const float inv = powf(10000.0f, -(float)(2 * f) / 64.0f); float s, c; sincosf((float)pos * inv, &s, &c); r64[i] = make_float2(c, s); }
    for (int i = gtid; i < LTOK * 64; i += ngt) { const int pos = i >> 6, f = i & 63; const float inv = powf(10000.0f, -(float)(2 * f) / 128.0f); float s, c; sincosf((float)pos * inv, &s, &c); r128[i] = make_float2(c, s); }
    float* hmeta = (float*)(pp->ws + WS_HMETA);
    for (int i = gtid; i < 256 * D; i += ngt) { const int m = i / D, cidx = i % D; hmeta[i] = pp->in[1][(size_t)(m & 15) * D + cidx]; }
    if (gw < 2) {
        const int l = gw; float* misc = (float*)(pp->ws + WS_MISC) + 16 * l;
        const float* lv = pp->in[9] + (size_t)l * 512;
        float d01 = lv[lane] * lv[128 + lane] + lv[64 + lane] * lv[192 + lane];
        float d23 = lv[256 + lane] * lv[384 + lane] + lv[320 + lane] * lv[448 + lane];
        d01 = wave_sum(d01); d23 = wave_sum(d23);
        const float lam_init = (l == 0) ? 0.2f : 0.35550907f;
        const float lam = expf(d01) - expf(d23) + lam_init;
        const float* qg = pp->in[7] + l * 128; const float* kg = pp->in[8] + l * 128;
        const float gq = wave_max(fmaxf(fabsf(qg[lane]), fabsf(qg[64 + lane]))), gk = wave_max(fmaxf(fabsf(kg[lane]), fabsf(kg[64 + lane])));
        const float dbound = 11.3137085f * gq * gk * 1.02f;
        const float nqg = wave_max(fabsf(pp->in[11][l * 64 + lane])), nkg = wave_max(fabsf(pp->in[12][l * 64 + lane]));
        float rm = 0.f; const float* rpb = pp->in[13] + (size_t)l * 7440;
        for (int i = lane; i < 7440; i += 64) rm = fmaxf(rm, fabsf(rpb[i]));
        rm = wave_max(rm);
        const float nbound = 8.0f * nqg * nkg * 1.02f + rm;
        if (lane == 0) { misc[0] = lam; misc[1] = dbound; misc[2] = nbound; misc[3] = lam_init; }
    }
}

__device__ __forceinline__ void prep_phase(ParamsCP pp, int layer, int gw, int ngw, int lane) {
    bf16_t* PROJ = (bf16_t*)(pp->ws + WS_BIG + BIG_PROJ);
    const float2* r64 = (const float2*)(pp->ws + WS_ROPE64); const float2* r128 = (const float2*)(pp->ws + WS_ROPE128);
    const float* dqg = pp->in[7] + layer * 128; const float* dkg = pp->in[8] + layer * 128;
    const float* nqg = pp->in[11] + layer * 64; const float* nkg = pp->in[12] + layer * 64;
    const int g4 = lane >> 4, l16 = lane & 15, g2 = lane >> 5, l32 = lane & 31;
    const float dq0 = dqg[2 * l32], dq1 = dqg[2 * l32 + 1], dq2 = dqg[64 + 2 * l32], dq3 = dqg[64 + 2 * l32 + 1];
    const float dk0 = dkg[2 * l32], dk1 = dkg[2 * l32 + 1], dk2 = dkg[64 + 2 * l32], dk3 = dkg[64 + 2 * l32 + 1];
    const f32x4 nq4 = *(const f32x4*)(nqg + 4 * l16), nk4 = *(const f32x4*)(nkg + 4 * l16);
    for (int m = gw; m < M; m += ngw) {
        const int pos = m < RB ? (m & 15) : 16 + ((m - RB) & (SEQ - 1));
        bf16_t* row = PROJ + (size_t)m * PP; bf16_t* rowD = row + PBUF; bf16_t* rowN = row + 2 * PBUF;
        const float2 c64a = r64[pos * 32 + 2 * l16], c64b = r64[pos * 32 + 2 * l16 + 1], c128a = r128[pos * 64 + 2 * l32], c128b = r128[pos * 64 + 2 * l32 + 1];
        unsigned r1[4], r2[4], d1[8], d2[8]; u32x2 nn[8];
#pragma unroll
        for (int ps = 0; ps < 4; ++ps) { const int grp = ps * 4 + g4; r1[ps] = *(const unsigned*)(row + grp * 64 + 2 * l16); r2[ps] = *(const unsigned*)(row + grp * 64 + 32 + 2 * l16); }
#pragma unroll
        for (int ps = 0; ps < 8; ++ps) { const int grp = ps * 2 + g2; d1[ps] = *(const unsigned*)(rowD + grp * 128 + 2 * l32); d2[ps] = *(const unsigned*)(rowD + grp * 128 + 64 + 2 * l32); }
#pragma unroll
        for (int ps = 0; ps < 8; ++ps) { const int grp = ps * 4 + g4; nn[ps] = *(const u32x2*)(rowN + grp * 64 + 4 * l16); }
#pragma unroll
        for (int ps = 0; ps < 4; ++ps) { const int grp = ps * 4 + g4; const float sc = grp >= 8 ? 0.125f : 1.0f;
            const float a0 = lo_f(r1[ps]), a1 = hi_f(r1[ps]), b0 = lo_f(r2[ps]), b1 = hi_f(r2[ps]);
            *(unsigned*)(row + grp * 64 + 2 * l16) = pk2((a0 * c64a.x - b0 * c64a.y) * sc, (a1 * c64b.x - b1 * c64b.y) * sc);
            *(unsigned*)(row + grp * 64 + 32 + 2 * l16) = pk2((a0 * c64a.y + b0 * c64a.x) * sc, (a1 * c64b.y + b1 * c64b.x) * sc); }
#pragma unroll
        for (int ps = 0; ps < 8; ++ps) { const int grp = ps * 2 + g2; const bool isk = grp >= 8;
            float a0 = lo_f(d1[ps]), a1 = hi_f(d1[ps]), b0 = lo_f(d2[ps]), b1 = hi_f(d2[ps]);
            float ss = (a0 * a0 + a1 * a1) + (b0 * b0 + b1 * b1);
#pragma unroll
            for (int o = 1; o < 32; o <<= 1) ss += __shfl_xor(ss, o);
            const float rstd = rsqrtf(ss * (1.0f / 128.0f) + EPS);
            a0 *= rstd * (isk ? dk0 : dq0); a1 *= rstd * (isk ? dk1 : dq1); b0 *= rstd * (isk ? dk2 : dq2); b1 *= rstd * (isk ? dk3 : dq3);
            *(unsigned*)(rowD + grp * 128 + 2 * l32) = pk2(a0 * c128a.x - b0 * c128a.y, a1 * c128b.x - b1 * c128b.y);
            *(unsigned*)(rowD + grp * 128 + 64 + 2 * l32) = pk2(a0 * c128a.y + b0 * c128a.x, a1 * c128b.y + b1 * c128b.x); }
#pragma unroll
        for (int ps = 0; ps < 8; ++ps) { const int grp = ps * 4 + g4; const f32x4 gn = grp >= 16 ? nk4 : nq4;
            const float a0 = lo_f(nn[ps].x), a1 = hi_f(nn[ps].x), a2 = lo_f(nn[ps].y), a3 = hi_f(nn[ps].y);
            float ss = (a0 * a0 + a1 * a1) + (a2 * a2 + a3 * a3);
#pragma unroll
            for (int o = 1; o < 16; o <<= 1) ss += __shfl_xor(ss, o);
            const float rstd = rsqrtf(ss * (1.0f / 64.0f) + EPS);
            u32x2 o2; o2.x = pk2(a0 * rstd * gn.x, a1 * rstd * gn.y); o2.y = pk2(a2 * rstd * gn.z, a3 * rstd * gn.w);
            *(u32x2*)(rowN + grp * 64 + 4 * l16) = o2; }
    }
}

__device__ __forceinline__ int act_prev_row(int m) { if (m < RB) return (m & 15) > 0 ? m - 1 : -1; const int s = (m - RB) & (SEQ - 1), b = (m - RB) >> 11; return s > 0 ? m - 1 : b * 16 + 15; }
__device__ __forceinline__ int act_next_row(int m) { if (m < RB) return (m & 15) < 15 ? m + 1 : RB + (m >> 4) * SEQ; const int s = (m - RB) & (SEQ - 1); return s < SEQ - 1 ? m + 1 : -1; }
__device__ __forceinline__ void act_phase(ParamsCP pp, int layer, int gtid, int ngt) {
    const bf16_t* Gb = (const bf16_t*)(pp->ws + WS_BIG + BIG_G); bf16_t* Vb = (bf16_t*)(pp->ws + WS_BIG + BIG_V);
    const float* cw = pp->in[20] + (size_t)layer * 3 * DFF; const float* cb = pp->in[21] + (size_t)layer * DFF;
    constexpr int NCH = DFF / 8, NRB = M / 8;
    for (int i = gtid; i < NRB * NCH; i += ngt) {
        const int rb = i / NCH, ch = i - rb * NCH, c0 = ch * 8, m0 = rb * 8;
        const int mp = act_prev_row(m0), mn = act_next_row(m0 + 7);
        const u32x4 z = (u32x4){0u, 0u, 0u, 0u};
        u32x4 g[10], v[8];
        g[0] = mp >= 0 ? *(const u32x4*)(Gb + (size_t)mp * DFF + c0) : z;
#pragma unroll
        for (int r = 0; r < 8; ++r) { g[r + 1] = *(const u32x4*)(Gb + (size_t)(m0 + r) * DFF + c0); v[r] = *(const u32x4*)(Vb + (size_t)(m0 + r) * DFF + c0); }
        g[9] = mn >= 0 ? *(const u32x4*)(Gb + (size_t)mn * DFF + c0) : z;
        float w0[8], w1[8], w2[8], bb[8];
#pragma unroll
        for (int j = 0; j < 8; ++j) { w0[j] = cw[c0 + j]; w1[j] = cw[DFF + c0 + j]; w2[j] = cw[2 * DFF + c0 + j]; bb[j] = cb[c0 + j]; }
#pragma unroll
        for (int r = 0; r < 8; ++r) {
            const unsigned gp[4] = {g[r].x, g[r].y, g[r].z, g[r].w}, gc[4] = {g[r + 1].x, g[r + 1].y, g[r + 1].z, g[r + 1].w}, gn[4] = {g[r + 2].x, g[r + 2].y, g[r + 2].z, g[r + 2].w}, vv[4] = {v[r].x, v[r].y, v[r].z, v[r].w};
            float o[8];
#pragma unroll
            for (int j = 0; j < 4; ++j) {
                const float a0 = lo_f(gp[j]) * w0[2 * j] + lo_f(gc[j]) * w1[2 * j] + lo_f(gn[j]) * w2[2 * j] + bb[2 * j];
                const float a1 = hi_f(gp[j]) * w0[2 * j + 1] + hi_f(gc[j]) * w1[2 * j + 1] + hi_f(gn[j]) * w2[2 * j + 1] + bb[2 * j + 1];
                o[2 * j] = a0 * sigmoid_f(a0) * lo_f(vv[j]); o[2 * j + 1] = a1 * sigmoid_f(a1) * hi_f(vv[j]);
            }
            u32x4 w; w.x = pk2(o[0], o[1]); w.y = pk2(o[2], o[3]); w.z = pk2(o[4], o[5]); w.w = pk2(o[6], o[7]);
            *(u32x4*)(Vb + (size_t)(m0 + r) * DFF + c0) = w;
        }
    }
}

template <int KS>
__device__ __forceinline__ void load_k(bf16x8 (&kf)[KS], const bf16_t* kp) {
#pragma unroll
    for (int ks = 0; ks < KS; ++ks) kf[ks] = *(const bf16x8*)(kp + 32 * ks);
}
template <int KS>
__device__ __forceinline__ f32x4 st_mma(const bf16x8 (&kf)[KS], const bf16x8 (&qf)[KS]) {
    f32x4 s = (f32x4){0.f, 0.f, 0.f, 0.f};
#pragma unroll
    for (int ks = 0; ks < KS; ++ks) s = mfma16(kf[ks], qf[ks], s);
    return s;
}
__device__ __forceinline__ bf16x8 pack_p(const float (&p0)[4], const float (&p1)[4]) {
    u32x4 w; w.x = pk2(p0[0], p0[1]); w.y = pk2(p0[2], p0[3]); w.z = pk2(p1[0], p1[1]); w.w = pk2(p1[2], p1[3]);
    return __builtin_bit_cast(bf16x8, w);
}
template <int NT>
__device__ __forceinline__ void pv_step(f32x4 (&acc)[NT], bf16x8 pf, const bf16_t* v0, const bf16_t* v1) {
    constexpr int GRP = NT < 8 ? NT : 8;
#pragma unroll
    for (int g0 = 0; g0 < NT; g0 += GRP) {
        u32x2 va[GRP], vb[GRP];
#pragma unroll
        for (int i = 0; i < GRP; ++i) { va[i] = *(const u32x2*)(v0 + (size_t)(g0 + i) * 16 * M); vb[i] = *(const u32x2*)(v1 + (size_t)(g0 + i) * 16 * M); }
#pragma unroll
        for (int i = 0; i < GRP; ++i) asm volatile("" : "+v"(va[i]), "+v"(vb[i]));
#pragma unroll
        for (int i = 0; i < GRP; ++i) { u32x4 w; w.x = va[i].x; w.y = va[i].y; w.z = vb[i].x; w.w = vb[i].y; acc[g0 + i] = mfma16(pf, __builtin_bit_cast(bf16x8, w), acc[g0 + i]); }
    }
}

constexpr int MX_KBYTES = 32 * 272, MX_VBYTES = 256 * 80, MX_BUF = MX_KBYTES + MX_VBYTES, MX_FLAG = 2 * MX_BUF;
constexpr size_t BIG_RO = BIG_VT + (size_t)NVT * M * 2;
static_assert(BIG_RO + (size_t)M * 1024 * 2 <= BIG_BYTES, "RO fits");
static_assert(MX_FLAG + 64 <= 131072, "mixer LDS fits");
template <int DK, int DV, bool DIFF>
__device__ __forceinline__ void wg_attn_task(ParamsCP pp, int layer, LAS unsigned char* lds, int b, int h, int qb, int tid) {
    constexpr int KS = DK / 32, NT = DV / 16, KP = DK * 2 + 16, VP = 80, KCH = DK / 8, NV = (DV * 4 + 511) / 512;
    const bf16_t* PROJ = (const bf16_t*)(pp->ws + WS_BIG + BIG_PROJ); const bf16_t* VT = (const bf16_t*)(pp->ws + WS_BIG + BIG_VT);
    const int lane = tid & 63, wave = __builtin_amdgcn_readfirstlane(tid >> 6), c16 = lane & 15, quad = lane >> 4;
    const size_t qcol = DIFF ? PBUF + h * 256 : (size_t)(C_RQ + h * 64);
    const size_t kcol = DIFF ? PBUF + 1024 + h * 256 : (size_t)(C_RK + h * 64);
    const int vrow0 = DIFF ? V_DIFF + h * 256 : V_RET + h * 128;
    const int jraw = qb * 8 + wave; const bool active = jraw < 129; const int jq = active ? jraw : 128;
    const int qrow0 = tile_row(b, jq);
    const bool kcopy = tid < 32 * KCH; const int krow = tid / KCH, kch = tid % KCH;
    float lam = 0.f, cb = 0.f; float lgf = 0.f, lgb = 0.f;
    if (DIFF) { const float* misc = (const float*)(pp->ws + WS_MISC) + 16 * layer; lam = misc[0]; cb = misc[1] * LOG2E; }
    else { lgf = log1pf(-exp2f(-pp->in[4][layer * 8 + h])) * LOG2E; lgb = log1pf(-exp2f(-pp->in[5][layer * 8 + h])) * LOG2E; }
    const float sc = 0.08838834764831845f * LOG2E;
    const int tq = 16 * jq + c16;
    f32x4 O[NT];
#pragma unroll
    for (int e0 = 0; e0 < NT; ++e0) O[e0] = (f32x4){0.f, 0.f, 0.f, 0.f};
#pragma unroll 1
    for (int half = 0; half < (DIFF ? 2 : 1); ++half) {
        bf16x8 qf[KS];
        { const bf16_t* qp = PROJ + (size_t)(qrow0 + c16) * PP + qcol + half * 128 + 8 * quad;
#pragma unroll
            for (int ks = 0; ks < KS; ++ks) qf[ks] = *(const bf16x8*)(qp + 32 * ks); }
        f32x4 acc[NT];
#pragma unroll
        for (int e0 = 0; e0 < NT; ++e0) acc[e0] = (f32x4){0.f, 0.f, 0.f, 0.f};
        float lsum = 0.f;
        const size_t kc = kcol + half * 128 + kch * 8;
        u32x4 kreg = (u32x4){0u, 0u, 0u, 0u}, vreg[NV];
#define MX_ISSUE(step) do { const int jt0_ = 2 * (step), jt1_ = jt0_ + 1 < 129 ? jt0_ + 1 : 128; const int kr0_ = tile_row(b, jt0_), kr1_ = tile_row(b, jt1_); \
            if (kcopy) kreg = *(const u32x4*)(PROJ + (size_t)(krow < 16 ? kr0_ + krow : kr1_ + krow - 16) * PP + kc); \
            _Pragma("unroll") for (int i_ = 0; i_ < NV; ++i_) { const int id_ = tid + 512 * i_, vr_ = id_ >> 2, vc_ = id_ & 3; \
                vreg[i_] = *(const u32x4*)(VT + (size_t)(vrow0 + vr_) * M + ((vc_ < 2 ? kr0_ : kr1_) + (vc_ & 1) * 8)); } } while (0)
#define MX_COMMIT(buf) do { LAS unsigned char* bb_ = lds + (buf) * MX_BUF; \
            if (kcopy) *(LAS u32x4*)(bb_ + krow * KP + kch * 16) = kreg; \
            _Pragma("unroll") for (int i_ = 0; i_ < NV; ++i_) { const int id_ = tid + 512 * i_, vr_ = id_ >> 2, vc_ = id_ & 3; \
                *(LAS u32x4*)(bb_ + MX_KBYTES + vr_ * VP + vc_ * 16) = vreg[i_]; } } while (0)
        __syncthreads();
        MX_ISSUE(0); MX_COMMIT(0);
        __syncthreads();
#pragma unroll 1
        for (int st = 0; st < 65; ++st) {
            const int buf = st & 1;
            if (st + 1 < 65) MX_ISSUE(st + 1);
            const LAS unsigned char* kb = lds + buf * MX_BUF; const LAS unsigned char* vb = kb + MX_KBYTES;
            bf16x8 k0[KS], k1[KS];
#pragma unroll
            for (int ks = 0; ks < KS; ++ks) { k0[ks] = *(const LAS bf16x8*)(kb + c16 * KP + (32 * ks + 8 * quad) * 2); k1[ks] = *(const LAS bf16x8*)(kb + (16 + c16) * KP + (32 * ks + 8 * quad) * 2); }
            const f32x4 s0 = st_mma<KS>(k0, qf), s1 = st_mma<KS>(k1, qf);
            const bool v1 = 2 * st + 1 < 129;
            float p0[4], p1[4];
#pragma unroll
            for (int r = 0; r < 4; ++r) {
                if (DIFF) { p0[r] = fast_exp2(s0[r] * sc - cb); p1[r] = v1 ? fast_exp2(s1[r] * sc - cb) : 0.f; lsum += p0[r] + p1[r]; }
                else { const int d0 = tq - (32 * st + 4 * quad + r), d1 = d0 - 16;
                    p0[r] = s0[r] * fast_exp2(d0 >= 0 ? (float)d0 * lgf : (float)(-d0) * lgb);
                    p1[r] = v1 ? s1[r] * fast_exp2(d1 >= 0 ? (float)d1 * lgf : (float)(-d1) * lgb) : 0.f; }
            }
            const bf16x8 pf = pack_p(p0, p1);
#pragma unroll
            for (int e0 = 0; e0 < NT; ++e0) {
                const u32x2 va = *(const LAS u32x2*)(vb + (e0 * 16 + c16) * VP + 8 * quad), vbb = *(const LAS u32x2*)(vb + (e0 * 16 + c16) * VP + 32 + 8 * quad);
                u32x4 w; w.x = va.x; w.y = va.y; w.z = vbb.x; w.w = vbb.y;
                acc[e0] = mfma16(pf, __builtin_bit_cast(bf16x8, w), acc[e0]);
            }
            if (st + 1 < 65) MX_COMMIT(buf ^ 1);
            __syncthreads();
        }
#undef MX_ISSUE
#undef MX_COMMIT
        if (DIFF) {
            lsum += __shfl_xor(lsum, 16); lsum += __shfl_xor(lsum, 32);
            float il[4];
#pragma unroll
            for (int r = 0; r < 4; ++r) il[r] = 1.0f / __shfl(lsum, 4 * quad + r);
            const float f = half == 0 ? 1.0f : -lam;
#pragma unroll
            for (int e0 = 0; e0 < NT; ++e0)
#pragma unroll
                for (int r = 0; r < 4; ++r) O[e0][r] += f * acc[e0][r] * il[r];
        } else {
#pragma unroll
            for (int e0 = 0; e0 < NT; ++e0) O[e0] = acc[e0];
        }
    }
    if (active) {
        bf16_t* yb = DIFF ? (bf16_t*)(pp->ws + WS_BIG + BIG_PROJ) + PBUF + (size_t)(qrow0 + 4 * quad) * PP + h * 256 + c16
                          : (bf16_t*)(pp->ws + WS_BIG + BIG_RO) + (size_t)(qrow0 + 4 * quad) * 1024 + h * 128 + c16;
        const int pitch = DIFF ? PP : 1024;
#pragma unroll
        for (int e0 = 0; e0 < NT; ++e0)
#pragma unroll
            for (int r = 0; r < 4; ++r) yb[(size_t)r * pitch + e0 * 16] = (bf16_t)f2bf(O[e0][r]);
    }
}
constexpr int DF_KP = 528, DF_KBYTES = 32 * DF_KP, DF_BUF = DF_KBYTES + MX_VBYTES;
static_assert(2 * DF_BUF <= MX_FLAG || 2 * DF_BUF + 64 <= 131072, "diff LDS");
constexpr int DF_FLAG = 2 * DF_BUF;
__device__ __forceinline__ void wg_diff_task(ParamsCP pp, int layer, LAS unsigned char* lds, int b, int h, int qb, int tid) {
    constexpr int VP = 80;
    const bf16_t* PROJ = (const bf16_t*)(pp->ws + WS_BIG + BIG_PROJ); const bf16_t* VT = (const bf16_t*)(pp->ws + WS_BIG + BIG_VT);
    const int lane = tid & 63, wave = __builtin_amdgcn_readfirstlane(tid >> 6), c16 = lane & 15, quad = lane >> 4;
    const size_t qcol = PBUF + h * 256, kcol = PBUF + 1024 + h * 256;
    const int vrow0 = V_DIFF + h * 256;
    const int jraw = qb * 8 + wave; const bool active = jraw < 129; const int jq = active ? jraw : 128;
    const int qrow0 = tile_row(b, jq);
    const float* misc = (const float*)(pp->ws + WS_MISC) + 16 * layer;
    const float lam = misc[0], cb = misc[1] * LOG2E, sc = 0.08838834764831845f * LOG2E;
    bf16x8 qf0[4], qf1[4];
    { const bf16_t* qp = PROJ + (size_t)(qrow0 + c16) * PP + qcol + 8 * quad;
#pragma unroll
        for (int ks = 0; ks < 4; ++ks) { qf0[ks] = *(const bf16x8*)(qp + 32 * ks); qf1[ks] = *(const bf16x8*)(qp + 128 + 32 * ks); } }
    f32x4 acc0[16], acc1[16];
#pragma unroll
    for (int e0 = 0; e0 < 16; ++e0) { acc0[e0] = (f32x4){0.f, 0.f, 0.f, 0.f}; acc1[e0] = (f32x4){0.f, 0.f, 0.f, 0.f}; }
    float ls0 = 0.f, ls1 = 0.f;
    u32x4 kreg[2], vreg[2];
#define DF_ISSUE(step) do { const int jt0_ = 2 * (step), jt1_ = jt0_ + 1 < 129 ? jt0_ + 1 : 128; const int kr0_ = tile_row(b, jt0_), kr1_ = tile_row(b, jt1_); \
        _Pragma("unroll") for (int i_ = 0; i_ < 2; ++i_) { const int id_ = tid + 512 * i_, kr_ = id_ >> 5, kc_ = id_ & 31, vr_ = id_ >> 2, vc_ = id_ & 3; \
            kreg[i_] = *(const u32x4*)(PROJ + (size_t)(kr_ < 16 ? kr0_ + kr_ : kr1_ + kr_ - 16) * PP + kcol + kc_ * 8); \
            vreg[i_] = *(const u32x4*)(VT + (size_t)(vrow0 + vr_) * M + ((vc_ < 2 ? kr0_ : kr1_) + (vc_ & 1) * 8)); } } while (0)
#define DF_COMMIT(buf) do { LAS unsigned char* bb_ = lds + (buf) * DF_BUF; \
        _Pragma("unroll") for (int i_ = 0; i_ < 2; ++i_) { const int id_ = tid + 512 * i_, kr_ = id_ >> 5, kc_ = id_ & 31, vr_ = id_ >> 2, vc_ = id_ & 3; \
            *(LAS u32x4*)(bb_ + kr_ * DF_KP + kc_ * 16) = kreg[i_]; *(LAS u32x4*)(bb_ + DF_KBYTES + vr_ * VP + vc_ * 16) = vreg[i_]; } } while (0)
    __syncthreads();
    DF_ISSUE(0); DF_COMMIT(0);
    __syncthreads();
#pragma unroll 1
    for (int st = 0; st < 65; ++st) {
        const int buf = st & 1;
        if (st + 1 < 65) DF_ISSUE(st + 1);
        const LAS unsigned char* kb = lds + buf * DF_BUF; const LAS unsigned char* vb = kb + DF_KBYTES;
        const bool v1 = 2 * st + 1 < 129;
        bf16x8 pf0, pf1;
        {   bf16x8 k0[4], k1[4];
#pragma unroll
            for (int ks = 0; ks < 4; ++ks) { k0[ks] = *(const LAS bf16x8*)(kb + c16 * DF_KP + (32 * ks + 8 * quad) * 2); k1[ks] = *(const LAS bf16x8*)(kb + (16 + c16) * DF_KP + (32 * ks + 8 * quad) * 2); }
            const f32x4 s0 = st_mma<4>(k0, qf0), s1 = st_mma<4>(k1, qf0);
            float p0[4], p1[4];
#pragma unroll
            for (int r = 0; r < 4; ++r) { p0[r] = fast_exp2(s0[r] * sc - cb); p1[r] = v1 ? fast_exp2(s1[r] * sc - cb) : 0.f; ls0 += p0[r] + p1[r]; }
            pf0 = pack_p(p0, p1); }
        {   bf16x8 k0[4], k1[4];
#pragma unroll
            for (int ks = 0; ks < 4; ++ks) { k0[ks] = *(const LAS bf16x8*)(kb + c16 * DF_KP + 256 + (32 * ks + 8 * quad) * 2); k1[ks] = *(const LAS bf16x8*)(kb + (16 + c16) * DF_KP + 256 + (32 * ks + 8 * quad) * 2); }
            const f32x4 s0 = st_mma<4>(k0, qf1), s1 = st_mma<4>(k1, qf1);
            float p0[4], p1[4];
#pragma unroll
            for (int r = 0; r < 4; ++r) { p0[r] = fast_exp2(s0[r] * sc - cb); p1[r] = v1 ? fast_exp2(s1[r] * sc - cb) : 0.f; ls1 += p0[r] + p1[r]; }
            pf1 = pack_p(p0, p1); }
#pragma unroll
        for (int e0 = 0; e0 < 16; ++e0) {
            const u32x2 va = *(const LAS u32x2*)(vb + (e0 * 16 + c16) * VP + 8 * quad), vbb = *(const LAS u32x2*)(vb + (e0 * 16 + c16) * VP + 32 + 8 * quad);
            u32x4 w; w.x = va.x; w.y = va.y; w.z = vbb.x; w.w = vbb.y; const bf16x8 vf = __builtin_bit_cast(bf16x8, w);
            acc0[e0] = mfma16(pf0, vf, acc0[e0]); acc1[e0] = mfma16(pf1, vf, acc1[e0]);
        }
        if (st + 1 < 65) DF_COMMIT(buf ^ 1);
        __syncthreads();
    }
#undef DF_ISSUE
#undef DF_COMMIT
    ls0 += __shfl_xor(ls0, 16); ls0 += __shfl_xor(ls0, 32); ls1 += __shfl_xor(ls1, 16); ls1 += __shfl_xor(ls1, 32);
    float i0[4], i1[4];
#pragma unroll
    for (int r = 0; r < 4; ++r) { i0[r] = fast_rcp(__shfl(ls0, 4 * quad + r)); i1[r] = lam * fast_rcp(__shfl(ls1, 4 * quad + r)); }
    if (active) {
        bf16_t* yb = (bf16_t*)(pp->ws + WS_BIG + BIG_PROJ) + PBUF + (size_t)(qrow0 + 4 * quad) * PP + h * 256 + c16;
#pragma unroll
        for (int e0 = 0; e0 < 16; ++e0)
#pragma unroll
            for (int r = 0; r < 4; ++r) yb[(size_t)r * PP + e0 * 16] = (bf16_t)f2bf(acc0[e0][r] * i0[r] - acc1[e0][r] * i1[r]);
    }
}
__device__ __forceinline__ void diff_post_phase(ParamsCP pp, int layer, int gw, int ngw, int lane) {
    bf16_t* PD = (bf16_t*)(pp->ws + WS_BIG + BIG_PROJ) + PBUF;
    const float* misc = (const float*)(pp->ws + WS_MISC) + 16 * layer;
    const float cl = 1.0f - misc[3];
    const float* og = pp->in[10] + layer * 256;
    const f32x4 g4 = *(const f32x4*)(og + 4 * lane);
    for (int m = gw; m < M; m += ngw) {
        u32x2 w[4];
#pragma unroll
        for (int h = 0; h < 4; ++h) w[h] = *(const u32x2*)(PD + (size_t)m * PP + h * 256 + 4 * lane);
#pragma unroll
        for (int h = 0; h < 4; ++h) {
            const float a0 = lo_f(w[h].x), a1 = hi_f(w[h].x), a2 = lo_f(w[h].y), a3 = hi_f(w[h].y);
            const float ss = wave_sum((a0 * a0 + a1 * a1) + (a2 * a2 + a3 * a3));
            const float rs = rsqrtf(ss * (1.0f / 256.0f) + EPS) * cl;
            u32x2 o2; o2.x = pk2(a0 * rs * g4.x, a1 * rs * g4.y); o2.y = pk2(a2 * rs * g4.z, a3 * rs * g4.w);
            *(u32x2*)(PD + (size_t)m * PP + h * 256 + 4 * lane) = o2;
        }
    }
}
__device__ __forceinline__ void wg_ret_task(ParamsCP pp, int layer, LAS unsigned char* lds, int b, int h, int qb, int tid) {
    constexpr int KP = 144, VP = 80;
    const bf16_t* PROJ = (const bf16_t*)(pp->ws + WS_BIG + BIG_PROJ); const bf16_t* VT = (const bf16_t*)(pp->ws + WS_BIG + BIG_VT);
    const int lane = tid & 63, wave = __builtin_amdgcn_readfirstlane(tid >> 6), c16 = lane & 15, quad = lane >> 4;
    const size_t qcol = C_RQ + h * 64, kcol = C_RK + h * 64;
    const int vrow0 = V_RET + h * 128;
    const int jrA = qb * 16 + wave, jrB = jrA + 8; const bool actA = jrA < 129, actB = jrB < 129; const int jA = actA ? jrA : 128, jB = actB ? jrB : 128;
    const int qrowA = tile_row(b, jA), qrowB = tile_row(b, jB);
    const bool kcopy = tid < 256; const int krow = (tid & 255) >> 3, kch = tid & 7, vr = tid >> 2, vc = tid & 3;
    const float lgf = log1pf(-exp2f(-pp->in[4][layer * 8 + h])) * LOG2E, lgb = log1pf(-exp2f(-pp->in[5][layer * 8 + h])) * LOG2E;
    const int tqA = 16 * jA + c16, tqB = 16 * jB + c16;
    bf16x8 qA[2], qB[2];
    { const bf16_t* qp = PROJ + (size_t)(qrowA + c16) * PP + qcol + 8 * quad; qA[0] = *(const bf16x8*)qp; qA[1] = *(const bf16x8*)(qp + 32);
      const bf16_t* qp2 = PROJ + (size_t)(qrowB + c16) * PP + qcol + 8 * quad; qB[0] = *(const bf16x8*)qp2; qB[1] = *(const bf16x8*)(qp2 + 32); }
    f32x4 accA[8], accB[8];
#pragma unroll
    for (int e0 = 0; e0 < 8; ++e0) { accA[e0] = (f32x4){0.f, 0.f, 0.f, 0.f}; accB[e0] = (f32x4){0.f, 0.f, 0.f, 0.f}; }
    u32x4 kr0s = (u32x4){0u, 0u, 0u, 0u}, vr0s = kr0s, kr1s = kr0s, vr1s = kr0s;
#define RT_ISSUE(KR, VR, step) do { const int s_ = (step) < 65 ? (step) : 64; const int jt0_ = 2 * s_, jt1_ = jt0_ + 1 < 129 ? jt0_ + 1 : 128; const int a0_ = tile_row(b, jt0_), a1_ = tile_row(b, jt1_); \
        if (kcopy) KR = *(const u32x4*)(PROJ + (size_t)(krow < 16 ? a0_ + krow : a1_ + krow - 16) * PP + kcol + kch * 8); \
        VR = *(const u32x4*)(VT + (size_t)(vrow0 + vr) * M + ((vc < 2 ? a0_ : a1_) + (vc & 1) * 8)); } while (0)
#define RT_COMMIT(KR, VR, buf) do { LAS unsigned char* bb_ = lds + (buf) * MX_BUF; \
        if (kcopy) *(LAS u32x4*)(bb_ + krow * KP + kch * 16) = KR; *(LAS u32x4*)(bb_ + MX_KBYTES + vr * VP + vc * 16) = VR; } while (0)
#define RT_COMPUTE(st, buf) do { const LAS unsigned char* kb = lds + (buf) * MX_BUF; const LAS unsigned char* vb = kb + MX_KBYTES; \
        bf16x8 k0[2], k1[2]; \
        _Pragma("unroll") for (int ks = 0; ks < 2; ++ks) { k0[ks] = *(const LAS bf16x8*)(kb + c16 * KP + (32 * ks + 8 * quad) * 2); k1[ks] = *(const LAS bf16x8*)(kb + (16 + c16) * KP + (32 * ks + 8 * quad) * 2); } \
        const f32x4 sA0 = st_mma<2>(k0, qA), sA1 = st_mma<2>(k1, qA), sB0 = st_mma<2>(k0, qB), sB1 = st_mma<2>(k1, qB); \
        const bool v1 = 2 * (st) + 1 < 129; float pa0[4], pa1[4], pb0[4], pb1[4]; \
        _Pragma("unroll") for (int r = 0; r < 4; ++r) { const int tk = 32 * (st) + 4 * quad + r; \
            const int dA0 = tqA - tk, dA1 = dA0 - 16, dB0 = tqB - tk, dB1 = dB0 - 16; \
            pa0[r] = sA0[r] * fast_exp2(dA0 >= 0 ? (float)dA0 * lgf : (float)(-dA0) * lgb); \
            pa1[r] = v1 ? sA1[r] * fast_exp2(dA1 >= 0 ? (float)dA1 * lgf : (float)(-dA1) * lgb) : 0.f; \
            pb0[r] = sB0[r] * fast_exp2(dB0 >= 0 ? (float)dB0 * lgf : (float)(-dB0) * lgb); \
            pb1[r] = v1 ? sB1[r] * fast_exp2(dB1 >= 0 ? (float)dB1 * lgf : (float)(-dB1) * lgb) : 0.f; } \
        const bf16x8 pfA = pack_p(pa0, pa1), pfB = pack_p(pb0, pb1); \
        _Pragma("unroll") for (int e0 = 0; e0 < 8; ++e0) { \
            const u32x2 va = *(const LAS u32x2*)(vb + (e0 * 16 + c16) * VP + 8 * quad), vbb = *(const LAS u32x2*)(vb + (e0 * 16 + c16) * VP + 32 + 8 * quad); \
            u32x4 w; w.x = va.x; w.y = va.y; w.z = vbb.x; w.w = vbb.y; const bf16x8 vf = __builtin_bit_cast(bf16x8, w); \
            accA[e0] = mfma16(pfA, vf, accA[e0]); accB[e0] = mfma16(pfB, vf, accB[e0]); } } while (0)
    __syncthreads();
    RT_ISSUE(kr0s, vr0s, 0); RT_COMMIT(kr0s, vr0s, 0); RT_ISSUE(kr1s, vr1s, 1);
    __syncthreads();
#pragma unroll 1
    for (int st = 0; st < 65; st += 2) {
        RT_ISSUE(kr0s, vr0s, st + 2); RT_COMPUTE(st, 0); RT_COMMIT(kr1s, vr1s, 1); __syncthreads();
        if (st + 1 < 65) { RT_ISSUE(kr1s, vr1s, st + 3); RT_COMPUTE(st + 1, 1); RT_COMMIT(kr0s, vr0s, 0); __syncthreads(); }
    }
#undef RT_ISSUE
#undef RT_COMMIT
#undef RT_COMPUTE
    bf16_t* ro = (bf16_t*)(pp->ws + WS_BIG + BIG_RO);
    if (actA) { bf16_t* yb = ro + (size_t)(qrowA + 4 * quad) * 1024 + h * 128 + c16;
#pragma unroll
        for (int e0 = 0; e0 < 8; ++e0)
#pragma unroll
            for (int r = 0; r < 4; ++r) yb[(size_t)r * 1024 + e0 * 16] = (bf16_t)f2bf(accA[e0][r]); }
    if (actB) { bf16_t* yb = ro + (size_t)(qrowB + 4 * quad) * 1024 + h * 128 + c16;
#pragma unroll
        for (int e0 = 0; e0 < 8; ++e0)
#pragma unroll
            for (int r = 0; r < 4; ++r) yb[(size_t)r * 1024 + e0 * 16] = (bf16_t)f2bf(accB[e0][r]); }
}
__device__ __forceinline__ void ret_post_phase(ParamsCP pp, int layer, int gw, int ngw, int lane) {
    bf16_t* PR = (bf16_t*)(pp->ws + WS_BIG + BIG_PROJ); const bf16_t* RO = (const bf16_t*)(pp->ws + WS_BIG + BIG_RO);
    const float* og = pp->in[6] + layer * 1024;
    float o0[8], o1[8];
#pragma unroll
    for (int h = 0; h < 8; ++h) { o0[h] = og[h * 128 + 2 * lane]; o1[h] = og[h * 128 + 2 * lane + 1]; }
    for (int m = gw; m < M; m += ngw) {
        unsigned w[8], gv[8];
#pragma unroll
        for (int h = 0; h < 8; ++h) { w[h] = *(const unsigned*)(RO + (size_t)m * 1024 + h * 128 + 2 * lane); gv[h] = *(const unsigned*)(PR + (size_t)m * PP + C_RG + h * 128 + 2 * lane); }
#pragma unroll
        for (int h = 0; h < 8; ++h) {
            const float a0 = lo_f(w[h]), a1 = hi_f(w[h]), g0 = lo_f(gv[h]), g1 = hi_f(gv[h]);
            const float ss = wave_sum(a0 * a0 + a1 * a1);
            const float rs = rsqrtf(ss * (1.0f / 128.0f) + EPS);
            *(unsigned*)(PR + (size_t)m * PP + C_RG + h * 128 + 2 * lane) = pk2(a0 * rs * o0[h] * g0 * sigmoid_f(g0), a1 * rs * o1[h] * g1 * sigmoid_f(g1));
        }
    }
}

__device__ __forceinline__ void na_task(ParamsCP pp, int layer, int b, int h, int r, int g, int lane) {
    const bf16_t* PROJ = (const bf16_t*)(pp->ws + WS_BIG + BIG_PROJ); const bf16_t* VT = (const bf16_t*)(pp->ws + WS_BIG + BIG_VT);
    const float* misc = (const float*)(pp->ws + WS_MISC) + 16 * layer;
    const float bound = misc[2];
    const float* rpb = pp->in[13] + (size_t)layer * 7440 + (size_t)h * 465;
    const int c16 = lane & 15, quad = lane >> 4;
    const bool meta = r < 0;
    const int qrow0 = meta ? b * 16 : RB + b * SEQ + r * 64 + 16 * g;
    bf16x8 qf[2];
    { const bf16_t* qp = PROJ + 2 * PBUF + (size_t)(qrow0 + c16) * PP + h * 64 + 8 * quad; qf[0] = *(const bf16x8*)qp; qf[1] = *(const bf16x8*)(qp + 32); }
    f32x4 acc[4];
#pragma unroll
    for (int e0 = 0; e0 < 4; ++e0) acc[e0] = (f32x4){0.f, 0.f, 0.f, 0.f};
    float lsum = 0.f;
    const size_t colk = 2 * PBUF + 1024 + h * 64 + 8 * quad;
    const bf16_t* vbase = VT + (size_t)(V_NA + h * 64 + c16) * M + 4 * quad;
    const int qc = 16 * g + c16;
    int cstart = qc - 8; cstart = cstart < 0 ? 0 : (cstart > 48 ? 48 : cstart);
    int rs = r - 4; rs = rs < 0 ? 0 : (rs > 24 ? 24 : rs);
    int cw0 = 16 * g - 8; cw0 = cw0 < 0 ? 0 : (cw0 > 32 ? 32 : cw0);
    int bi0[4], bi1[4]; bool ok0[4], ok1[4];
#pragma unroll
    for (int rr = 0; rr < 4; ++rr) { const int kc0 = cw0 + 4 * quad + rr, kc1 = kc0 + 16;
        int i0 = kc0 - qc + 15; i0 = i0 < 0 ? 0 : (i0 > 30 ? 30 : i0); int i1 = kc1 - qc + 15; i1 = i1 < 0 ? 0 : (i1 > 30 ? 30 : i1);
        bi0[rr] = i0; bi1[rr] = i1; ok0[rr] = kc0 >= cstart && kc0 < cstart + 16; ok1[rr] = kc1 >= cstart && kc1 < cstart + 16; }
    bf16x8 ck0[2], ck1[2], nk0[2], nk1[2]; u32x2 cva[4], cvb[4], nva[4], nvb[4]; float cb0[4], cb1[4], nb0[4], nb1[4];
#define NA_LOAD(K0, K1, VA, VB, B0, B1, s_) do { const bool win_ = (s_) < 8; const int kr0_ = win_ ? RB + b * SEQ + (rs + (s_)) * 64 + cw0 : b * 16; const int kr1_ = win_ ? kr0_ + 16 : kr0_; \
        load_k<2>(K0, PROJ + (size_t)(kr0_ + c16) * PP + colk); load_k<2>(K1, PROJ + (size_t)(kr1_ + c16) * PP + colk); \
        _Pragma("unroll") for (int e_ = 0; e_ < 4; ++e_) { VA[e_] = *(const u32x2*)(vbase + kr0_ + (size_t)e_ * 16 * M); VB[e_] = *(const u32x2*)(vbase + kr1_ + (size_t)e_ * 16 * M); } \
        const float* brow_ = rpb + (win_ ? (rs + (s_) - r + 7) * 31 : 0); \
        _Pragma("unroll") for (int rr_ = 0; rr_ < 4; ++rr_) { B0[rr_] = brow_[bi0[rr_]]; B1[rr_] = brow_[bi1[rr_]]; } } while (0)
    const int sfirst = meta ? 8 : 0;
    NA_LOAD(ck0, ck1, cva, cvb, cb0, cb1, sfirst);
#pragma unroll 1
    for (int s = sfirst; s < 9; ++s) {
        const bool win = s < 8;
        if (s + 1 < 9) NA_LOAD(nk0, nk1, nva, nvb, nb0, nb1, s + 1);
        asm volatile("" ::: "memory");
        const f32x4 s0 = st_mma<2>(ck0, qf), s1 = st_mma<2>(ck1, qf);
        float p0[4], p1[4];
#pragma unroll
        for (int rr = 0; rr < 4; ++rr) {
            if (win) { p0[rr] = ok0[rr] ? fast_exp2((s0[rr] * 0.125f + cb0[rr] - bound) * LOG2E) : 0.f; p1[rr] = ok1[rr] ? fast_exp2((s1[rr] * 0.125f + cb1[rr] - bound) * LOG2E) : 0.f; }
            else { p0[rr] = fast_exp2((s0[rr] * 0.125f - bound) * LOG2E); p1[rr] = 0.f; }
            lsum += p0[rr] + p1[rr];
        }
        const bf16x8 pf = pack_p(p0, p1);
#pragma unroll
        for (int e0 = 0; e0 < 4; ++e0) { u32x4 w; w.x = cva[e0].x; w.y = cva[e0].y; w.z = cvb[e0].x; w.w = cvb[e0].y; acc[e0] = mfma16(pf, __builtin_bit_cast(bf16x8, w), acc[e0]); }
#pragma unroll
        for (int i = 0; i < 2; ++i) { ck0[i] = nk0[i]; ck1[i] = nk1[i]; }
#pragma unroll
        for (int i = 0; i < 4; ++i) { cva[i] = nva[i]; cvb[i] = nvb[i]; cb0[i] = nb0[i]; cb1[i] = nb1[i]; }
    }
#undef NA_LOAD
    lsum += __shfl_xor(lsum, 16); lsum += __shfl_xor(lsum, 32);
    float il[4];
#pragma unroll
    for (int rr = 0; rr < 4; ++rr) il[rr] = 1.0f / __shfl(lsum, 4 * quad + rr);
    bf16_t* yb = (bf16_t*)(pp->ws + WS_BIG + BIG_PROJ) + 2 * PBUF + (size_t)(qrow0 + 4 * quad) * PP + h * 64 + c16;
#pragma unroll
    for (int e0 = 0; e0 < 4; ++e0)
#pragma unroll
        for (int rr = 0; rr < 4; ++rr) yb[(size_t)rr * PP + e0 * 16] = (bf16_t)f2bf(acc[e0][rr] * il[rr]);
}

constexpr int TW_DIFF = NBATCH * 4 * 17, TW_RET = NBATCH * 8 * 9, TW_TOTAL = TW_DIFF + TW_RET;
constexpr int T_NA = NBATCH * 16 * 128, T_NAM = NBATCH * 16, T_NATOTAL = T_NA + T_NAM;
__device__ __forceinline__ void mixer_phase(ParamsCP pp, int layer, LAS unsigned char* lds, int tid) {
    unsigned* ctrw = (unsigned*)(pp->ws + WS_CTL) + 64 * layer; unsigned* ctrn = ctrw + 128;
    const int lane = tid & 63;
    LAS unsigned* flag = (LAS unsigned*)(lds + DF_FLAG);
    for (;;) {
        __syncthreads();
        if (tid == 0) *flag = atomicAdd(ctrw, 1u);
        __syncthreads();
        const int q = (int)__builtin_amdgcn_readfirstlane((int)*flag);
        if (q >= TW_TOTAL) break;
        if (q < TW_DIFF) { const int b = q / 68, rem = q - b * 68, h = rem / 17, qb = rem - h * 17; wg_diff_task(pp, layer, lds, b, h, qb, tid); }
        else { const int q2 = q - TW_DIFF; const int b = q2 / 72, rem = q2 - b * 72, h = rem / 9, qb = rem - h * 9; wg_ret_task(pp, layer, lds, b, h, qb, tid); }
    }
    for (;;) {
        unsigned t = 0;
        if (lane == 0) t = atomicAdd(ctrn, 1u);
        t = (unsigned)__builtin_amdgcn_readfirstlane((int)t);
        if (t >= (unsigned)T_NATOTAL) break;
        int q = (int)t;
        if (q < T_NA) { const int b = q >> 11, rem = q & 2047, h = rem >> 7, rg = rem & 127; na_task(pp, layer, b, h, rg >> 2, rg & 3, lane); continue; }
        q -= T_NA;
        na_task(pp, layer, q >> 4, q & 15, -1, 0, lane);
    }
}

#define XB_TMO      128
#define XB_XCNT(j)  (256  + 64 * (j))
#define XB_XSUB(j)  (1280 + 64 * (j))
#define XB_XGEN(j)  (2304 + 64 * (j))
#define XB_TOP      3328
#define XB_TOPGEN   3392
#define XCD_BAR_WORDS 3456
#define XB_SPIN_CAP (1u << 18)
constexpr int CW_BAR = 1024;
static_assert((CW_BAR + XCD_BAR_WORDS) * 4 <= (int)CTL_BYTES, "barrier words inside the memset region");
__device__ __forceinline__ unsigned xb_ld(unsigned* p)              { return __hip_atomic_load(p, __ATOMIC_RELAXED, __HIP_MEMORY_SCOPE_AGENT); }
__device__ __forceinline__ unsigned xb_add(unsigned* p, unsigned v) { return __hip_atomic_fetch_add(p, v, __ATOMIC_RELAXED, __HIP_MEMORY_SCOPE_AGENT); }
__device__ __forceinline__ unsigned xb_xcc_id() { return (unsigned)__builtin_amdgcn_s_getreg((3 << 11) | 20) & 0xFu; }
#define XB_SPIN(cond, bar) do { unsigned _sp = 0; while (cond) { __builtin_amdgcn_s_sleep(1); \
    if ((++_sp & 255u) == 0u) { if (xb_ld(&(bar)[XB_TMO])) break; if (_sp > XB_SPIN_CAP) { atomicAdd(&(bar)[XB_TMO], 1u); break; } } } } while (0)
struct XcdBarrier { unsigned* bar; unsigned x; volatile LAS unsigned* st; };
__device__ __forceinline__ XcdBarrier xcd_barrier_post(unsigned* bar, volatile LAS unsigned* st) {
    XcdBarrier b; b.bar = bar; b.x = xb_xcc_id(); b.st = st;
    if (threadIdx.x == 0) (void)xb_add(&bar[XB_XCNT(b.x)], 1u);
    return b;
}
__device__ __forceinline__ void xcd_barrier_complete(unsigned* bar, unsigned x, unsigned& nloc, unsigned& nx) {
    const unsigned G = gridDim.x * gridDim.y * gridDim.z;
    unsigned sum, cnt, mine, sp = 0u;
    for (;;) {
        sum = 0u; cnt = 0u; mine = 0u;
#pragma unroll
        for (unsigned j = 0; j < 16; ++j) { const unsigned c = xb_ld(&bar[XB_XCNT(j)]); sum += c; cnt += (c > 0u) ? 1u : 0u; mine = (j == x) ? c : mine; }
        if (sum == G) break;
        __builtin_amdgcn_s_sleep(1);
        if ((++sp & 255u) == 0u) { if (xb_ld(&bar[XB_TMO])) break; if (sp > XB_SPIN_CAP) { atomicAdd(&bar[XB_TMO], 1u); break; } }
    }
    nloc = mine > 0u ? mine : 1u; nx = cnt > 0u ? cnt : 1u;
}
__device__ __forceinline__ void xcd_barrier(const XcdBarrier& b) {
    asm volatile("s_waitcnt vmcnt(0)" ::: "memory");
    __syncthreads();
    if (threadIdx.x == 0) {
        unsigned* bar = b.bar;
        __builtin_amdgcn_s_waitcnt(0);
        unsigned nloc = b.st[0], nx = b.st[1];
        if (nloc == 0u) { xcd_barrier_complete(bar, b.x, nloc, nx); b.st[0] = nloc; b.st[1] = nx; }
        const unsigned old = xb_add(&bar[XB_XSUB(b.x)], 1u);
        const unsigned gen = old / nloc;
        if (old + 1u == (gen + 1u) * nloc) {
            __builtin_amdgcn_fence(__ATOMIC_RELEASE, "agent");
            asm volatile("s_waitcnt vmcnt(0)" ::: "memory");
            const unsigned og = xb_add(&bar[XB_TOP], 1u);
            const unsigned tg = og / nx;
            if (og + 1u == (tg + 1u) * nx) xb_add(&bar[XB_TOPGEN], 1u);
            else XB_SPIN(xb_ld(&bar[XB_TOPGEN]) == tg, bar);
            __builtin_amdgcn_fence(__ATOMIC_ACQUIRE, "agent");
            xb_add(&bar[XB_XGEN(b.x)], 1u);
            asm volatile("s_waitcnt vmcnt(0)" ::: "memory");
        } else {
            XB_SPIN(xb_ld(&bar[XB_XGEN(b.x)]) == gen, bar);
            __builtin_amdgcn_fence(__ATOMIC_ACQUIRE, "agent");
            asm volatile("s_waitcnt vmcnt(0)" ::: "memory");
        }
    }
    __syncthreads();
}
__global__ void __launch_bounds__(512) fwd_kernel(Params p_unused) {
    extern __shared__ __attribute__((aligned(16))) unsigned char lds_raw[];
    LAS unsigned char* lds = (LAS unsigned char*)lds_raw;
    cg::grid_group grid = cg::this_grid();
    const int G = gridDim.x, blk = blockIdx.x;
    const int ngw = G * 8, ngt = G * 512;
    {
        volatile LAS unsigned* xst = (volatile LAS unsigned*)(lds + 131072 + 64);
        if (threadIdx.x == 0) { xst[0] = 0u; xst[1] = 0u; }
        __syncthreads();
        (void)xcd_barrier_post((unsigned*)(get_params()->ws + WS_CTL) + CW_BAR, xst);
        grid.sync();
    }
#define GRID_SYNC() do { asm volatile("s_waitcnt vmcnt(0) lgkmcnt(0)" ::: "memory"); { XcdBarrier xb_; xb_.bar = (unsigned*)(get_params()->ws + WS_CTL) + CW_BAR; xb_.x = xb_xcc_id(); xb_.st = (volatile LAS unsigned*)(lds + 131072 + 64); xcd_barrier(xb_); } asm volatile("" ::: "memory"); } while (0)
#define FRESH_IDS() int tid = threadIdx.x; asm volatile("" : "+v"(tid)); const int lane = tid & 63, wave = __builtin_amdgcn_readfirstlane(tid >> 6), gw = blk * 8 + wave, gtid = blk * 512 + tid; (void)lane; (void)gw; (void)gtid

    { unsigned* ctl0 = (unsigned*)(get_params()->ws + WS_CTL);
      if (blk == 0 && threadIdx.x < 4) __hip_atomic_store(ctl0 + 64 * threadIdx.x, 0u, __ATOMIC_RELAXED, __HIP_MEMORY_SCOPE_AGENT); }
#pragma unroll 1
    for (int layer = 0; layer < 2; ++layer) {
        { FRESH_IDS(); ParamsCP pp = get_params();
          convert_weights(pp, layer, lds, gw, ngw, wave, lane);
          if (layer == 0) setup_phase(pp, gtid, ngt, gw, lane);
          norm_phase(pp, pp->in[2] + layer * D, layer == 0, gw, ngw, lane); }
        GRID_SYNC();
        { FRESH_IDS(); ParamsCP pp = get_params(); unsigned char* ws = pp->ws;
          SchedIn S{(const char*)(ws + WS_U), (const char*)(ws + WS_WT + WT_IN), G, blk}; EpiIn E{(bf16_t*)(ws + WS_BIG + BIG_PROJ), (bf16_t*)(ws + WS_BIG + BIG_VT)}; pg8::gemm_phase(lds, S, E, tid); }
        GRID_SYNC();
        { FRESH_IDS(); ParamsCP pp = get_params(); prep_phase(pp, layer, gw, ngw, lane); }
        GRID_SYNC();
        { FRESH_IDS(); ParamsCP pp = get_params(); mixer_phase(pp, layer, lds, tid); }
        GRID_SYNC();
        { FRESH_IDS(); ParamsCP pp = get_params(); diff_post_phase(pp, layer, gw, ngw, lane); ret_post_phase(pp, layer, gw, ngw, lane); }
        GRID_SYNC();
#pragma unroll 1
        for (int br = 0; br < 3; ++br) {
            { FRESH_IDS(); ParamsCP pp = get_params(); unsigned char* ws = pp->ws;
              SchedPlain S{(const char*)(ws + WS_U), (const char*)(ws + WS_WT + WT_IN + (size_t)(9216 + br * 2048) * 4096), 4096u, 4096u, 32, 129, 8, 0, G, blk};
              EpiGate E{(bf16_t*)(ws + WS_BIG + BIG_GATE)}; pg8::gemm_phase(lds, S, E, tid); }
            GRID_SYNC();
            { FRESH_IDS(); ParamsCP pp = get_params(); unsigned char* ws = pp->ws;
              const size_t yoff = ((size_t)br * PBUF + (br == 0 ? 1024 : 0)) * 2;
              SchedPlain S{(const char*)(ws + WS_BIG + BIG_PROJ + yoff), (const char*)(ws + WS_WT + WT_BR + (size_t)br * 2048 * 4096), 4096u, 4096u, 16, 129, 8, 0, G, blk};
              EpiYM E{(const bf16_t*)(ws + WS_BIG + BIG_GATE), (bf16_t*)(ws + WS_BIG + BIG_MERGED), br == 0 ? 1 : 0}; pg8::gemm_phase(lds, S, E, tid); }
            GRID_SYNC();
        }
        { FRESH_IDS(); ParamsCP pp = get_params(); unsigned char* ws = pp->ws; float* hmeta = (float*)(ws + WS_HMETA);
          SchedPlain S{(const char*)(ws + WS_BIG + BIG_MERGED), (const char*)(ws + WS_WT + WT_OUT), 4096u, 4096u, 32, 129, 8, 0, G, blk};
          EpiResid E{layer == 0 ? pp->in[0] : (const float*)pp->out, hmeta, pp->out, hmeta}; pg8::gemm_phase(lds, S, E, tid); }
        GRID_SYNC();
        { FRESH_IDS(); ParamsCP pp = get_params(); norm_phase(pp, pp->in[18] + layer * D, false, gw, ngw, lane); }
        GRID_SYNC();
        { FRESH_IDS(); ParamsCP pp = get_params(); unsigned char* ws = pp->ws;
          SchedPlain S{(const char*)(ws + WS_U), (const char*)(ws + WS_WT + WT_UP), 4096u, 4096u, 32, 129, 43, 0, G, blk};
          EpiUp E{(bf16_t*)(ws + WS_BIG + BIG_G), (bf16_t*)(ws + WS_BIG + BIG_V)}; pg8::gemm_phase(lds, S, E, tid); }
        GRID_SYNC();
        { FRESH_IDS(); ParamsCP pp = get_params(); act_phase(pp, layer, gtid, ngt); }
        GRID_SYNC();
        { FRESH_IDS(); ParamsCP pp = get_params(); unsigned char* ws = pp->ws; float* hmeta = (float*)(ws + WS_HMETA);
          const int skip = layer == 1 ? 1 : 0;
          SchedPlain S{(const char*)(ws + WS_BIG + BIG_V), (const char*)(ws + WS_WT + WT_DOWN), (unsigned)(DFF * 2), (unsigned)(DFF * 2), DFF / 64, 129 - skip, 8, skip, G, blk};
          EpiResid E{(const float*)pp->out, hmeta, pp->out, hmeta}; pg8::gemm_phase(lds, S, E, tid); }
        if (layer == 0) GRID_SYNC();
    }
}

constexpr int LDS_BYTES = 131072 + 4096;
extern "C" void kernel_launch(void* const* d_in, const int* in_sizes, int n_in, void* d_out, int out_size, void* d_ws, size_t ws_size, hipStream_t stream) {
    static int grid = 0;
    if (grid == 0) {
        if (n_in != 23 || ws_size < WS_END) { fprintf(stderr, "kernel_launch: need 23 inputs and >= %zu bytes of workspace (got %d, %zu)\n", (size_t)WS_END, n_in, ws_size); grid = -1; return; }
        int dev = 0, cus = 0, per_cu = 0;
        hipGetDevice(&dev);
        hipDeviceGetAttribute(&cus, hipDeviceAttributeMultiprocessorCount, dev);
        if (hipFuncSetAttribute((const void*)fwd_kernel, hipFuncAttributeMaxDynamicSharedMemorySize, LDS_BYTES) != hipSuccess) { fprintf(stderr, "kernel_launch: hipFuncSetAttribute failed\n"); grid = -1; return; }
        if (hipOccupancyMaxActiveBlocksPerMultiprocessor(&per_cu, (const void*)fwd_kernel, 512, LDS_BYTES) != hipSuccess || per_cu < 1) { fprintf(stderr, "kernel_launch: occupancy query failed (%d)\n", per_cu); per_cu = 1; }
        (void)hipGetLastError();
        grid = cus * per_cu; if (grid > 256) grid = 256;
    }
    if (grid < 0) return;
    hipMemsetAsync((char*)d_ws + WS_CTL, 0, CTL_BYTES, stream);
    Params p{};
    for (int i = 0; i < 23; ++i) p.in[i] = (const float*)d_in[i];
    p.out = (float*)d_out; p.ws = (unsigned char*)d_ws;
    void* args[] = {&p};
    hipError_t e = hipLaunchCooperativeKernel((const void*)fwd_kernel, dim3(grid), dim3(512), args, LDS_BYTES, stream);
    if (e != hipSuccess) fprintf(stderr, "cooperative launch failed: %s (grid %d)\n", hipGetErrorString(e), grid);
}
```

```cpp
#include <hip/hip_runtime.h>
#include <hip/hip_cooperative_groups.h>
#include <cstdio>
#include <cstdint>
namespace cg = cooperative_groups;

#define LAS __attribute__((address_space(3)))
typedef unsigned short bf16_t;
typedef short bf16x8 __attribute__((ext_vector_type(8)));
typedef short bf16x4 __attribute__((ext_vector_type(4)));
typedef float f32x4 __attribute__((ext_vector_type(4)));
typedef unsigned u32x4 __attribute__((ext_vector_type(4)));
typedef unsigned u32x2 __attribute__((ext_vector_type(2)));

constexpr int D = 2048, NBATCH = 16, SEQ = 2048, NMETA = 16, LTOK = 2064;
constexpr int M = 33024;
constexpr int RB = 256;
constexpr int NPROJ = 6144;
constexpr int PP = 2048;
constexpr size_t PBUF = (size_t)M * PP;
constexpr int NVT = 3072;
constexpr int NIN = 15360, DFF = 5504;
constexpr int C_RQ = 0, C_RK = 512, C_RG = 1024, C_DQ = 2048, C_DK = 3072, C_NQ = 4096, C_NK = 5120;
constexpr int V_RET = 0, V_DIFF = 1024, V_NA = 2048;
constexpr float EPS = 1e-6f;
constexpr float LOG2E = 1.4426950408889634f;

constexpr size_t WS_CTL = 0;
constexpr size_t CTL_BYTES = 32768;
constexpr size_t WS_MISC = 32768;
constexpr size_t WS_ROPE64 = 65536;
constexpr size_t WS_ROPE128 = WS_ROPE64 + (size_t)LTOK * 32 * 8;
constexpr size_t WS_HMETA = 2u << 20;
constexpr size_t WS_GATEM = 4u << 20;
constexpr size_t WS_WT = 8u << 20;
constexpr size_t WT_IN = 0;
constexpr size_t WT_BR = WT_IN + (size_t)NIN * D * 2;
constexpr size_t WT_OUT = WT_BR + (size_t)3 * D * 2048 * 2;
constexpr size_t WT_UP = WT_OUT + (size_t)D * D * 2;
constexpr size_t WT_DOWN = WT_UP + (size_t)2 * DFF * D * 2;
constexpr size_t WT_BYTES = WT_DOWN + (size_t)D * DFF * 2;
constexpr size_t WS_U = WS_WT + WT_BYTES;
constexpr size_t WS_BIG = WS_U + (size_t)M * D * 2;
constexpr size_t BIG_PROJ = 0;
constexpr size_t BIG_VT = (size_t)M * NPROJ * 2;
constexpr size_t BIG_MERGED = BIG_VT;
constexpr size_t BIG_GATE = BIG_MERGED + (size_t)M * D * 2;
constexpr size_t BIG_G = 0;
constexpr size_t BIG_V = (size_t)M * DFF * 2;
constexpr size_t BIG_BYTES = (size_t)2 * M * DFF * 2;
constexpr size_t WS_END = WS_BIG + BIG_BYTES;
static_assert(BIG_GATE + (size_t)M * D * 2 <= BIG_BYTES, "merged + gate buffers fit behind PROJ");
static_assert(BIG_VT + (size_t)NVT * M * 2 <= BIG_BYTES, "mixer buffers fit");
static_assert(WS_ROPE128 + (size_t)LTOK * 64 * 8 <= WS_HMETA, "rope tables");

struct Params {
    const float* in[23];
    float* out;
    unsigned char* ws;
};
typedef const Params __attribute__((address_space(4)))* ParamsCP;
__device__ __forceinline__ ParamsCP get_params() { ParamsCP q = (ParamsCP)__builtin_amdgcn_kernarg_segment_ptr(); asm volatile("" : "+s"(q)); return q; }

__device__ __forceinline__ float bf2f(unsigned short b) { return __uint_as_float(((unsigned)b) << 16); }
typedef __bf16 bf16x2_t __attribute__((ext_vector_type(2)));
typedef float f32x2_t __attribute__((ext_vector_type(2)));
__device__ __forceinline__ unsigned pk2(float lo, float hi) { f32x2_t v = {lo, hi}; bf16x2_t b = __builtin_convertvector(v, bf16x2_t); return __builtin_bit_cast(unsigned, b); }
__device__ __forceinline__ unsigned f2bf(float f) { return pk2(f, 0.f) & 0xffffu; }
__device__ __forceinline__ float lo_f(unsigned w) { return __uint_as_float(w << 16); }
__device__ __forceinline__ float hi_f(unsigned w) { return __uint_as_float(w & 0xffff0000u); }
__device__ __forceinline__ unsigned cvt_pk_bf16(float lo, float hi) { return pk2(lo, hi); }
__device__ __forceinline__ float wave_sum(float v) {
#pragma unroll
    for (int o = 1; o < 64; o <<= 1) v += __shfl_xor(v, o);
    return v;
}
__device__ __forceinline__ float wave_max(float v) {
#pragma unroll
    for (int o = 1; o < 64; o <<= 1) v = fmaxf(v, __shfl_xor(v, o));
    return v;
}
__device__ __forceinline__ float fast_exp2(float x) { return __builtin_amdgcn_exp2f(x); }
__device__ __forceinline__ float fast_rcp(float x) { return __builtin_amdgcn_rcpf(x); }
__device__ __forceinline__ float uniform_f(float x) { return __uint_as_float((unsigned)__builtin_amdgcn_readfirstlane((int)__float_as_uint(x))); }
__device__ __forceinline__ f32x4 mfma16(bf16x8 a, bf16x8 b, f32x4 c) { return __builtin_amdgcn_mfma_f32_16x16x32_bf16(a, b, c, 0, 0, 0); }
template <class T> __device__ __forceinline__ T* uniform_ptr(T* p) {
    const unsigned long long v = (unsigned long long)p;
    const unsigned lo = (unsigned)__builtin_amdgcn_readfirstlane((int)(unsigned)v), hi = (unsigned)__builtin_amdgcn_readfirstlane((int)(unsigned)(v >> 32));
    return (T*)(((unsigned long long)hi << 32) | lo);
}
__device__ __forceinline__ int tile_row(int b, int j) { return j == 0 ? b * 16 : (RB - 16) + b * SEQ + 16 * j; }

namespace pg8 {
constexpr int BM = 256, BK = 64, HALF = 128, HTB = HALF * BK * 2, STAGE_BYTES = 8 * HTB, NXCD = 8, WGM = 8;
__device__ __forceinline__ int lds_byte(int r, int c) { const int st = (r >> 4) * 2 + (c >> 5), rr = r & 15, cc = c & 31, ob = rr * 64 + cc * 2; return st * 1024 + (ob ^ (((ob >> 9) & 1) << 5)); }
__device__ __forceinline__ void stage_rc(int b, int& R, int& C) { const int st = b / 1024, sb = b % 1024, swz = sb ^ (((sb >> 9) & 1) << 5); R = (st >> 1) * 16 + swz / 64; C = (st & 1) * 32 + (swz % 64) / 2; }
__device__ __forceinline__ int perm32(int rho) { const int n = rho >> 4, i = rho & 15; return 8 * (i >> 2) + 4 * n + (i & 3); }

struct GUnit { const char* A; const char* B; unsigned lda, ldb; int nt, kind, pm, pn; };

__device__ __forceinline__ void tile_map(int L, int nM, int nN, int& pm, int& pn) {
    const int nwg = nM * nN; int wgid = L;
    { const int q = nwg / NXCD, r = nwg % NXCD, xcd = wgid % NXCD, off = wgid / NXCD; wgid = (xcd < r ? xcd * (q + 1) : r * (q + 1) + (xcd - r) * q) + off; }
    const int nig = WGM * nN, gid = wgid / nig, fm = gid * WGM, gsz = (nM - fm) < WGM ? (nM - fm) : WGM;
    pm = fm + ((wgid % nig) % gsz); pn = (wgid % nig) / gsz;
}

template <class Epi, class Sched>
__device__ __forceinline__ void gemm_phase(LAS unsigned char* lds, const Sched& S, const Epi& E, const int tid) {
    const int wid = __builtin_amdgcn_readfirstlane(tid >> 6), lane = tid & 63, wr = wid >> 2, wc = wid & 3, fr = lane & 15, fq = lane >> 4;
    int sR[2], sC[2], sRbi[2];
#pragma unroll
    for (int i = 0; i < 2; ++i) { stage_rc(tid * 16 + i * 8192, sR[i], sC[i]); sRbi[i] = (sR[i] & ~31) + perm32(sR[i] & 31); }
    const unsigned ldsw = (unsigned)wid * 1024u;
    const int aoff = lds_byte(wr * 64 + fr, fq * 8), boff = lds_byte(wc * 32 + fr, fq * 8);
#define PG8_SA(b, h) (((b) * 2 + (h)) * HTB)
#define PG8_SB(b, h) ((4 + (b) * 2 + (h)) * HTB)
#define PG8_STAGE(bufoff, gbase, rows) do { _Pragma("unroll") for (int _i = 0; _i < 2; ++_i) \
        __builtin_amdgcn_global_load_lds((const unsigned*)((const char*)(gbase) + (rows)[_i]), (LAS unsigned*)(lds + (bufoff) + ldsw + _i * 8192), 16, 0, 0); } while (0)
#define PG8_LDA(dst, b, h) do { _Pragma("unroll") for (int m = 0; m < 4; ++m) _Pragma("unroll") for (int k = 0; k < 2; ++k) dst[m][k] = *(const LAS bf16x8*)(lds + PG8_SA(b, h) + aoff + m * 2048 + k * 1024); } while (0)
#define PG8_LDB(dst, b, h) do { _Pragma("unroll") for (int n = 0; n < 2; ++n) _Pragma("unroll") for (int k = 0; k < 2; ++k) dst[n][k] = *(const LAS bf16x8*)(lds + PG8_SB(b, h) + boff + n * 2048 + k * 1024); } while (0)
#define PG8_MMA(ai, bj, At, Bt) do { __builtin_amdgcn_s_setprio(1); _Pragma("unroll") for (int m = 0; m < 4; ++m) _Pragma("unroll") for (int n = 0; n < 2; ++n) _Pragma("unroll") for (int k = 0; k < 2; ++k) \
        acc[ai][bj][m][n] = __builtin_amdgcn_mfma_f32_16x16x32_bf16(Bt[n][k], At[m][k], acc[ai][bj][m][n], 0, 0, 0); __builtin_amdgcn_s_setprio(0); } while (0)
#define PG8_WAIT_V(n) asm volatile("s_waitcnt vmcnt(" #n ")" ::: "memory")
#define PG8_WAIT_L(n) asm volatile("s_waitcnt lgkmcnt(" #n ")" ::: "memory")
#define PG8_BAR __builtin_amdgcn_s_barrier()
#define PG8_SCHED __builtin_amdgcn_sched_barrier(0)
    GUnit cur, nxt; int ui = 0;
    if (!S.next(0, cur)) return;
    f32x4 acc[2][2][4][2];
#pragma unroll
    for (int a = 0; a < 2; ++a)
#pragma unroll
        for (int b = 0; b < 2; ++b)
#pragma unroll
            for (int m = 0; m < 4; ++m)
#pragma unroll
                for (int n = 0; n < 2; ++n) acc[a][b][m][n] = (f32x4){0.f, 0.f, 0.f, 0.f};
    bf16x8 At[4][2], B0[2][2], B1[2][2];
    const char* cA = cur.A; const char* cB = cur.B;
    constexpr unsigned kstep = (unsigned)(BK * 2);
    const unsigned lda = cur.lda, ldb = cur.ldb, hA = HALF * lda, hB = HALF * ldb;
    unsigned vA[2], vB[2];
#pragma unroll
    for (int i = 0; i < 2; ++i) { vA[i] = (unsigned)sR[i] * lda + (unsigned)sC[i] * 2u; vB[i] = (unsigned)sRbi[i] * ldb + (unsigned)sC[i] * 2u; }
    PG8_STAGE(PG8_SB(0, 0), cB, vB); PG8_STAGE(PG8_SB(0, 1), cB + hB, vB); PG8_STAGE(PG8_SA(0, 0), cA, vA); PG8_STAGE(PG8_SA(0, 1), cA + hA, vA);
    if (wr == 1) PG8_BAR;
    PG8_WAIT_V(2); PG8_BAR;
    PG8_STAGE(PG8_SB(1, 0), cB + kstep, vB); PG8_STAGE(PG8_SA(1, 0), cA + kstep, vA); PG8_STAGE(PG8_SB(1, 1), cB + hB + kstep, vB);
    PG8_WAIT_V(6); PG8_BAR;
    for (;;) {
        const bool has_next = S.next(ui + 1, nxt);
        const char* nA = has_next ? nxt.A : cA; const char* nB = has_next ? nxt.B : cB;
        const int nt = cur.nt;
        for (int t = 0; t < nt; t += 2) {
            const bool last = (t == nt - 2);
            const char* a1 = cA + (size_t)(t + 1) * kstep;
            const char* a2 = last ? nA : cA + (size_t)(t + 2) * kstep; const char* b2 = last ? nB : cB + (size_t)(t + 2) * kstep;
            const char* a3 = a2 + kstep; const char* b3 = b2 + kstep;
            PG8_LDB(B0, 0, 0); PG8_LDB(B1, 0, 1); PG8_SCHED; PG8_LDA(At, 0, 0); PG8_STAGE(PG8_SA(1, 1), a1 + hA, vA);
            PG8_WAIT_V(8); PG8_WAIT_L(0); PG8_BAR; PG8_MMA(0, 0, At, B0); PG8_MMA(0, 1, At, B1); PG8_BAR; PG8_SCHED;
            PG8_LDA(At, 0, 1); PG8_STAGE(PG8_SB(0, 0), b2, vB); PG8_STAGE(PG8_SB(0, 1), b2 + hB, vB); PG8_STAGE(PG8_SA(0, 0), a2, vA);
            PG8_WAIT_V(8); PG8_WAIT_L(0); PG8_BAR; PG8_MMA(1, 0, At, B0); PG8_MMA(1, 1, At, B1); PG8_BAR; PG8_SCHED;
            PG8_LDB(B0, 1, 0); PG8_LDB(B1, 1, 1); PG8_SCHED; PG8_LDA(At, 1, 0); PG8_STAGE(PG8_SA(0, 1), a2 + hA, vA);
            PG8_WAIT_V(8); PG8_WAIT_L(0); PG8_BAR; PG8_MMA(0, 0, At, B0); PG8_MMA(0, 1, At, B1); PG8_BAR; PG8_SCHED;
            PG8_LDA(At, 1, 1); PG8_STAGE(PG8_SB(1, 0), b3, vB); PG8_STAGE(PG8_SB(1, 1), b3 + hB, vB); PG8_STAGE(PG8_SA(1, 0), a3, vA);
            PG8_WAIT_V(8); PG8_WAIT_L(0); PG8_BAR; PG8_MMA(1, 0, At, B0); PG8_MMA(1, 1, At, B1); PG8_BAR; PG8_SCHED;
        }
        if (wr == 0) PG8_BAR;
        E(acc, cur);
        if (!has_next) break;
#pragma unroll
        for (int a = 0; a < 2; ++a)
#pragma unroll
            for (int b = 0; b < 2; ++b)
#pragma unroll
                for (int m = 0; m < 4; ++m)
#pragma unroll
                    for (int n = 0; n < 2; ++n) acc[a][b][m][n] = (f32x4){0.f, 0.f, 0.f, 0.f};
        cur = nxt; cA = nA; cB = nB; ++ui;
        if (wr == 1) PG8_BAR;
    }
    PG8_WAIT_V(0);
    PG8_BAR;
#undef PG8_SA
#undef PG8_SB
#undef PG8_STAGE
#undef PG8_LDA
#undef PG8_LDB
#undef PG8_MMA
#undef PG8_WAIT_V
#undef PG8_WAIT_L
#undef PG8_BAR
#undef PG8_SCHED
}
}
using pg8::GUnit;

struct SchedIn {
    const char* U; const char* WT; int G, c;
    __device__ __forceinline__ bool next(int i, GUnit& u) const {
        const int L = i * G + c; int pm, pn;
        if (L < 3096) { pg8::tile_map(L, 129, 24, pm, pn); u.A = U + (size_t)pm * 256 * 4096; u.B = WT + (size_t)pn * 256 * 4096; u.kind = 0; }
        else if (L < 3096 + 1548) { pg8::tile_map(L - 3096, 12, 129, pm, pn); u.A = WT + (size_t)(NPROJ + pm * 256) * 4096; u.B = U + (size_t)pn * 256 * 4096; u.kind = 1; }
        else if (L < 3096 + 1548 + 24) { const int idx = L - (3096 + 1548); pm = idx >> 3; pn = idx & 7;
            u.A = U; u.B = WT + (size_t)(9216 + pm * 2048 + pn * 256) * 4096; u.kind = 2; }
        else return false;
        u.pm = pm; u.pn = pn; u.lda = 4096; u.ldb = 4096; u.nt = 32; return true;
    }
};
struct SchedPlain {
    const char* A; const char* B; unsigned lda, ldb; int nt, nM, nN, pm0, G, c;
    __device__ __forceinline__ bool next(int i, GUnit& u) const {
        const int L = i * G + c; if (L >= nM * nN) return false;
        int pm, pn; pg8::tile_map(L, nM, nN, pm, pn); pm += pm0;
        u.pm = pm; u.pn = pn; u.kind = 0; u.A = A + (size_t)pm * 256 * lda; u.B = B + (size_t)pn * 256 * ldb; u.lda = lda; u.ldb = ldb; u.nt = nt; return true;
    }
};

struct LaneId { int wr, wc, fr, fq; };
__device__ __forceinline__ LaneId lane_id_fresh() { int t = threadIdx.x; asm volatile("" : "+v"(t)); LaneId r; r.wr = t >> 8; r.wc = (t >> 6) & 3; r.fr = t & 15; r.fq = (t >> 4) & 3; return r; }
__device__ __forceinline__ float sigmoid_f(float x) { return fast_rcp(1.0f + fast_exp2(-x * LOG2E)); }
struct EpiIn {
    bf16_t* PROJ; bf16_t* VT; bf16_t* GATEM;
    __device__ __forceinline__ void operator()(const f32x4 (&acc)[2][2][4][2], const GUnit& u) const {
        const LaneId L_ = lane_id_fresh(); const int wr = L_.wr, wc = L_.wc, fr = L_.fr, fq = L_.fq;
        char* base; unsigned ldb2;
        if (u.kind == 0) { base = (char*)(PROJ + (size_t)(u.pn >> 3) * PBUF + (size_t)u.pm * 256 * PP + (size_t)(u.pn & 7) * 256); ldb2 = PP * 2; }
        else if (u.kind == 1) { base = (char*)(VT + (size_t)u.pm * 256 * M + (size_t)u.pn * 256); ldb2 = M * 2; }
        else { base = (char*)(GATEM + (size_t)u.pm * 256 * D + (size_t)u.pn * 256); ldb2 = D * 2; }
        base = uniform_ptr(base);
        const unsigned lo = (unsigned)(wr * 64 + fr) * ldb2 + (unsigned)(wc * 32 + 8 * fq) * 2u;
        const bool sg = u.kind == 2;
#pragma unroll
        for (int ai = 0; ai < 2; ++ai)
#pragma unroll
            for (int m = 0; m < 4; ++m) { const unsigned ro = lo + (unsigned)(ai * 128 + m * 16) * ldb2;
#pragma unroll
                for (int bj = 0; bj < 2; ++bj) { f32x4 v0 = acc[ai][bj][m][0], v1 = acc[ai][bj][m][1];
                    if (sg) {
#pragma unroll
                        for (int j = 0; j < 4; ++j) { v0[j] = sigmoid_f(v0[j]); v1[j] = sigmoid_f(v1[j]); } }
                    u32x4 w; w.x = cvt_pk_bf16(v0[0], v0[1]); w.y = cvt_pk_bf16(v0[2], v0[3]); w.z = cvt_pk_bf16(v1[0], v1[1]); w.w = cvt_pk_bf16(v1[2], v1[3]);
                    *(u32x4*)(base + (ro + bj * 256u)) = w; } }
    }
};
struct EpiGate {
    bf16_t* GATE;
    __device__ __forceinline__ void operator()(const f32x4 (&acc)[2][2][4][2], const GUnit& u) const {
        const LaneId L_ = lane_id_fresh(); const int wr = L_.wr, wc = L_.wc, fr = L_.fr, fq = L_.fq;
        char* gb = uniform_ptr((char*)(GATE + (size_t)u.pm * 256 * D + (size_t)u.pn * 256));
        const unsigned lo = (unsigned)(wr * 64 + fr) * (D * 2u) + (unsigned)(wc * 32 + 8 * fq) * 2u;
#pragma unroll
        for (int ai = 0; ai < 2; ++ai)
#pragma unroll
            for (int m = 0; m < 4; ++m)
#pragma unroll
                for (int bj = 0; bj < 2; ++bj) { const f32x4 v0 = acc[ai][bj][m][0], v1 = acc[ai][bj][m][1];
                    u32x4 w; w.x = cvt_pk_bf16(sigmoid_f(v0[0]), sigmoid_f(v0[1])); w.y = cvt_pk_bf16(sigmoid_f(v0[2]), sigmoid_f(v0[3]));
                    w.z = cvt_pk_bf16(sigmoid_f(v1[0]), sigmoid_f(v1[1])); w.w = cvt_pk_bf16(sigmoid_f(v1[2]), sigmoid_f(v1[3]));
                    *(u32x4*)(gb + (lo + (unsigned)(ai * 128 + m * 16) * (D * 2u) + bj * 256u)) = w; }
    }
};
struct EpiYM {
    const bf16_t* GATE; bf16_t* MERGED; int first; const bf16_t* GATEM;
    __device__ __forceinline__ void operator()(const f32x4 (&acc)[2][2][4][2], const GUnit& u) const {
        const LaneId L_ = lane_id_fresh(); const int wr = L_.wr, wc = L_.wc, fr = L_.fr, fq = L_.fq;
        const size_t tb = (size_t)u.pm * 256 * D + (size_t)u.pn * 256;
        const char* gb = uniform_ptr((const char*)(u.pm == 0 ? GATEM + (size_t)u.pn * 256 : GATE + tb)); char* mgb = uniform_ptr((char*)(MERGED + tb));
        const unsigned lo = (unsigned)(wr * 64 + fr) * (D * 2u) + (unsigned)(wc * 32 + 8 * fq) * 2u;
#pragma unroll
        for (int ai = 0; ai < 2; ++ai) {
            u32x4 gq[4][2], pq[4][2];
#pragma unroll
            for (int m = 0; m < 4; ++m)
#pragma unroll
                for (int bj = 0; bj < 2; ++bj) { const unsigned o = lo + (unsigned)(ai * 128 + m * 16) * (D * 2u) + bj * 256u;
                    gq[m][bj] = *(const u32x4*)(gb + o); pq[m][bj] = first ? (u32x4){0u, 0u, 0u, 0u} : *(const u32x4*)(mgb + o); }
#pragma unroll
            for (int m = 0; m < 4; ++m)
#pragma unroll
                for (int bj = 0; bj < 2; ++bj) { const f32x4 v0 = acc[ai][bj][m][0], v1 = acc[ai][bj][m][1];
                    const unsigned o = lo + (unsigned)(ai * 128 + m * 16) * (D * 2u) + bj * 256u;
                    const u32x4 g = gq[m][bj], p = pq[m][bj];
                    float r[8];
                    r[0] = v0[0] * lo_f(g.x) + lo_f(p.x); r[1] = v0[1] * hi_f(g.x) + hi_f(p.x); r[2] = v0[2] * lo_f(g.y) + lo_f(p.y); r[3] = v0[3] * hi_f(g.y) + hi_f(p.y);
                    r[4] = v1[0] * lo_f(g.z) + lo_f(p.z); r[5] = v1[1] * hi_f(g.z) + hi_f(p.z); r[6] = v1[2] * lo_f(g.w) + lo_f(p.w); r[7] = v1[3] * hi_f(g.w) + hi_f(p.w);
                    u32x4 w; w.x = cvt_pk_bf16(r[0], r[1]); w.y = cvt_pk_bf16(r[2], r[3]); w.z = cvt_pk_bf16(r[4], r[5]); w.w = cvt_pk_bf16(r[6], r[7]);
                    *(u32x4*)(mgb + o) = w; }
            asm volatile("" ::: "memory");
        }
    }
};
struct EpiResid {
    const float* in_real; const float* in_meta; float* out_real; float* out_meta;
    __device__ __forceinline__ void operator()(const f32x4 (&acc)[2][2][4][2], const GUnit& u) const {
        const LaneId L_ = lane_id_fresh(); const int wr = L_.wr, wc = L_.wc, fr = L_.fr, fq = L_.fq;
        const char* ip; char* op;
        if (u.pm == 0) { ip = (const char*)(in_meta + u.pn * 256); op = (char*)(out_meta + u.pn * 256); }
        else { ip = (const char*)(in_real + (size_t)(u.pm - 1) * 256 * D + u.pn * 256); op = (char*)(out_real + (size_t)(u.pm - 1) * 256 * D + u.pn * 256); }
        ip = uniform_ptr(ip); op = uniform_ptr(op);
        const unsigned lo = (unsigned)(wr * 64 + fr) * (D * 4u) + (unsigned)(wc * 32 + 8 * fq) * 4u;
#pragma unroll
        for (int ai = 0; ai < 2; ++ai) {
            f32x4 ra[4][2], rb[4][2];
#pragma unroll
            for (int m = 0; m < 4; ++m)
#pragma unroll
                for (int bj = 0; bj < 2; ++bj) { const unsigned o = lo + (unsigned)(ai * 128 + m * 16) * (D * 4u) + bj * 512u; ra[m][bj] = *(const f32x4*)(ip + o); rb[m][bj] = *(const f32x4*)(ip + (o + 16u)); }
#pragma unroll
            for (int m = 0; m < 4; ++m)
#pragma unroll
                for (int bj = 0; bj < 2; ++bj) { const unsigned o = lo + (unsigned)(ai * 128 + m * 16) * (D * 4u) + bj * 512u;
                    *(f32x4*)(op + o) = ra[m][bj] + acc[ai][bj][m][0]; *(f32x4*)(op + (o + 16u)) = rb[m][bj] + acc[ai][bj][m][1]; }
            asm volatile("" ::: "memory");
        }
    }
};
struct EpiUp {
    bf16_t* Gb; bf16_t* Vb;
    __device__ __forceinline__ void operator()(const f32x4 (&acc)[2][2][4][2], const GUnit& u) const {
        const LaneId L_ = lane_id_fresh(); const int wr = L_.wr, wc = L_.wc, fr = L_.fr, fq = L_.fq;
        const size_t tb = (size_t)u.pm * 256 * DFF + (size_t)u.pn * 128;
        char* gb = uniform_ptr((char*)(Gb + tb)); char* vb = uniform_ptr((char*)(Vb + tb));
        const unsigned lo = (unsigned)(wr * 64 + fr) * (DFF * 2u) + (unsigned)(wc * 32 + 8 * fq) * 2u;
#pragma unroll
        for (int ai = 0; ai < 2; ++ai)
#pragma unroll
            for (int m = 0; m < 4; ++m)
#pragma unroll
                for (int bj = 0; bj < 2; ++bj) { const f32x4 v0 = acc[ai][bj][m][0], v1 = acc[ai][bj][m][1];
                    u32x4 w; w.x = cvt_pk_bf16(v0[0], v0[1]); w.y = cvt_pk_bf16(v0[2], v0[3]); w.z = cvt_pk_bf16(v1[0], v1[1]); w.w = cvt_pk_bf16(v1[2], v1[3]);
                    *(u32x4*)((bj == 0 ? gb : vb) + (lo + (unsigned)(ai * 128 + m * 16) * (DFF * 2u))) = w; }
    }
};

__device__ __forceinline__ void transpose_item(const float* W, int K, int N, bf16_t* WT, int pitch, int kb, int n0, int drow0, LAS float* scr, int lane) {
    const int k0 = 64 * kb;
#pragma unroll 8
    for (int i = 0; i < 32; ++i) { const int kk = 2 * i + (lane >> 5); scr[kk * 33 + (lane & 31)] = W[(size_t)(k0 + kk) * N + n0 + (lane & 31)]; }
    asm volatile("s_waitcnt lgkmcnt(0)" ::: "memory");
    const int c = lane & 7;
#pragma unroll
    for (int j = 0; j < 4; ++j) { const int n = (lane >> 3) + 8 * j; const LAS float* s = scr + (8 * c) * 33 + n;
        u32x4 o; o.x = pk2(s[0 * 33], s[1 * 33]); o.y = pk2(s[2 * 33], s[3 * 33]); o.z = pk2(s[4 * 33], s[5 * 33]); o.w = pk2(s[6 * 33], s[7 * 33]);
        *(u32x4*)(WT + (size_t)(drow0 + n) * pitch + k0 + 8 * c) = o; }
    asm volatile("s_waitcnt lgkmcnt(0)" ::: "memory");
}
__device__ __forceinline__ int remap_in(int n) {
    if (n < 1024) return n;
    if (n < 2048) return NPROJ + V_RET + (n - 1024);
    if (n < 3072) return C_RG + (n - 2048);
    if (n < 5120) return C_DQ + (n - 3072);
    if (n < 6144) return NPROJ + V_DIFF + (n - 5120);
    if (n < 8192) return C_NQ + (n - 6144);
    if (n < 9216) return NPROJ + V_NA + (n - 8192);
    return n;
}
__device__ __forceinline__ int remap_up(int n) { return n < DFF ? (n / 128) * 256 + (n % 128) : ((n - DFF) / 128) * 256 + 128 + ((n - DFF) % 128); }

__device__ __forceinline__ void convert_weights(ParamsCP pp, int layer, LAS unsigned char* lds, int gw, int ngw, int wave, int lane) {
    LAS float* scr = (LAS float*)(lds + wave * 16384);
    unsigned char* wt = pp->ws + WS_WT;
    constexpr int I_IN = (D / 64) * (NIN / 32), I_BR = (1024 / 64) * (D / 32), I_OUT = (D / 64) * (D / 32), I_UP = (D / 64) * (2 * DFF / 32), I_DN = (DFF / 64) * (D / 32);
    constexpr int NITEMS = I_IN + 3 * I_BR + I_OUT + I_UP + I_DN;
    for (int it = gw; it < NITEMS; it += ngw) {
        int r = it;
        if (r < I_IN) { const int nblk = NIN / 32, kb = r / nblk, n0 = 32 * (r % nblk);
            transpose_item(pp->in[3] + (size_t)layer * D * NIN, D, NIN, (bf16_t*)(wt + WT_IN), D, kb, n0, remap_in(n0), scr, lane); continue; }
        r -= I_IN;
        if (r < 3 * I_BR) { const int br = r / I_BR; r -= br * I_BR; const int nblk = D / 32, kb = r / nblk, n0 = 32 * (r % nblk);
            transpose_item(pp->in[14 + br] + (size_t)layer * 1024 * D, 1024, D, (bf16_t*)(wt + WT_BR) + (size_t)br * D * 2048, 2048, kb, n0, n0, scr, lane); continue; }
        r -= 3 * I_BR;
        if (r < I_OUT) { const int nblk = D / 32, kb = r / nblk, n0 = 32 * (r % nblk);
            transpose_item(pp->in[17] + (size_t)layer * D * D, D, D, (bf16_t*)(wt + WT_OUT), D, kb, n0, n0, scr, lane); continue; }
        r -= I_OUT;
        if (r < I_UP) { const int nblk = 2 * DFF / 32, kb = r / nblk, n0 = 32 * (r % nblk);
            transpose_item(pp->in[19] + (size_t)layer * D * 2 * DFF, D, 2 * DFF, (bf16_t*)(wt + WT_UP), D, kb, n0, remap_up(n0), scr, lane); continue; }
        r -= I_UP;
        { const int nblk = D / 32, kb = r / nblk, n0 = 32 * (r % nblk);
            transpose_item(pp->in[22] + (size_t)layer * DFF * D, DFF, D, (bf16_t*)(wt + WT_DOWN), DFF, kb, n0, n0, scr, lane); }
    }
}

__device__ __forceinline__ void norm_row(const float* hrow, const float* g, bf16_t* urow, int lane) {
    const f32x4* xr = (const f32x4*)hrow + lane; const f32x4* gr = (const f32x4*)g + lane;
    f32x4 v[8], gg[8]; float s = 0.f;
#pragma unroll
    for (int j = 0; j < 8; ++j) { v[j] = xr[64 * j]; gg[j] = gr[64 * j]; }
#pragma unroll
    for (int j = 0; j < 8; ++j) s += (v[j].x * v[j].x + v[j].y * v[j].y) + (v[j].z * v[j].z + v[j].w * v[j].w);
    const float rstd = rsqrtf(wave_sum(s) * (1.0f / D) + EPS);
    u32x2* o8 = (u32x2*)urow + lane;
#pragma unroll
    for (int j = 0; j < 8; ++j) { u32x2 w; w.x = pk2(v[j].x * rstd * gg[j].x, v[j].y * rstd * gg[j].y); w.y = pk2(v[j].z * rstd * gg[j].z, v[j].w * rstd * gg[j].w); o8[64 * j] = w; }
}
__device__ __forceinline__ void norm_phase(ParamsCP pp, const float* gain, bool layer0_input, int gw, int ngw, int lane) {
    bf16_t* U = (bf16_t*)(pp->ws + WS_U); const float* hmeta = (const float*)(pp->ws + WS_HMETA);
    for (int m = gw; m < M; m += ngw) {
        const float* hrow;
        if (m < RB) hrow = layer0_input ? pp->in[1] + (size_t)(m & 15) * D : hmeta + (size_t)m * D;
        else hrow = (layer0_input ? pp->in[0] : (const float*)pp->out) + (size_t)(m - RB) * D;
        norm_row(hrow, gain, U + (size_t)m * D, lane);
    }
}

__device__ __forceinline__ void setup_phase(ParamsCP pp, int gtid, int ngt, int gw, int lane) {
    float2* r64 = (float2*)(pp->ws + WS_ROPE64); float2* r128 = (float2*)(pp->ws + WS_ROPE128);
    for (int i = gtid; i < LTOK * 32; i += ngt) { const int pos = i >> 5, f = i & 31; const float inv = powf(10000.0f, -(float)(2 * f) / 64.0f); float s, c; sincosf((float)pos * inv, &s, &c); r64[i] = make_float2(c, s); }
    for (int i = gtid; i < LTOK * 64; i += ngt) { const int pos = i >> 6, f = i & 63; const float inv = powf(10000.0f, -(float)(2 * f) / 128.0f); float s, c; sincosf((float)pos * inv, &s, &c); r128[i] = make_float2(c, s); }
    float* hmeta = (float*)(pp->ws + WS_HMETA);
    for (int i = gtid; i < 256 * D; i += ngt) { const int m = i / D, cidx = i % D; hmeta[i] = pp->in[1][(size_t)(m & 15) * D + cidx]; }
    if (gw < 2) {
        const int l = gw; float* misc = (float*)(pp->ws + WS_MISC) + 16 * l;
        const float* lv = pp->in[9] + (size_t)l * 512;
        float d01 = lv[lane] * lv[128 + lane] + lv[64 + lane] * lv[192 + lane];
        float d23 = lv[256 + lane] * lv[384 + lane] + lv[320 + lane] * lv[448 + lane];
        d01 = wave_sum(d01); d23 = wave_sum(d23);
        const float lam_init = (l == 0) ? 0.2f : 0.35550907f;
        const float lam = expf(d01) - expf(d23) + lam_init;
        const float* qg = pp->in[7] + l * 128; const float* kg = pp->in[8] + l * 128;
        const float gq = wave_max(fmaxf(fabsf(qg[lane]), fabsf(qg[64 + lane]))), gk = wave_max(fmaxf(fabsf(kg[lane]), fabsf(kg[64 + lane])));
        const float dbound = 11.3137085f * gq * gk * 1.02f;
        const float nqg = wave_max(fabsf(pp->in[11][l * 64 + lane])), nkg = wave_max(fabsf(pp->in[12][l * 64 + lane]));
        float rm = 0.f; const float* rpb = pp->in[13] + (size_t)l * 7440;
        for (int i = lane; i < 7440; i += 64) rm = fmaxf(rm, fabsf(rpb[i]));
        rm = wave_max(rm);
        const float nbound = 8.0f * nqg * nkg * 1.02f + rm;
        if (lane == 0) { misc[0] = lam; misc[1] = dbound; misc[2] = nbound; misc[3] = lam_init; }
    }
}

__device__ __forceinline__ void prep_phase(ParamsCP pp, int layer, int gw, int ngw, int lane) {
    bf16_t* PROJ = (bf16_t*)(pp->ws + WS_BIG + BIG_PROJ);
    const float2* r64 = (const float2*)(pp->ws + WS_ROPE64); const float2* r128 = (const float2*)(pp->ws + WS_ROPE128);
    const float* dqg = pp->in[7] + layer * 128; const float* dkg = pp->in[8] + layer * 128;
    const float* nqg = pp->in[11] + layer * 64; const float* nkg = pp->in[12] + layer * 64;
    const int g4 = lane >> 4, l16 = lane & 15, g2 = lane >> 5, l32 = lane & 31;
    const float dq0 = dqg[2 * l32], dq1 = dqg[2 * l32 + 1], dq2 = dqg[64 + 2 * l32], dq3 = dqg[64 + 2 * l32 + 1];
    const float dk0 = dkg[2 * l32], dk1 = dkg[2 * l32 + 1], dk2 = dkg[64 + 2 * l32], dk3 = dkg[64 + 2 * l32 + 1];
    const f32x4 nq4 = *(const f32x4*)(nqg + 4 * l16), nk4 = *(const f32x4*)(nkg + 4 * l16);
    for (int m = gw; m < M; m += ngw) {
        const int pos = m < RB ? (m & 15) : 16 + ((m - RB) & (SEQ - 1));
        bf16_t* row = PROJ + (size_t)m * PP; bf16_t* rowD = row + PBUF; bf16_t* rowN = row + 2 * PBUF;
        const float2 c64a = r64[pos * 32 + 2 * l16], c64b = r64[pos * 32 + 2 * l16 + 1], c128a = r128[pos * 64 + 2 * l32], c128b = r128[pos * 64 + 2 * l32 + 1];
        unsigned r1[4], r2[4], d1[8], d2[8]; u32x2 nn[8];
#pragma unroll
        for (int ps = 0; ps < 4; ++ps) { const int grp = ps * 4 + g4; r1[ps] = *(const unsigned*)(row + grp * 64 + 2 * l16); r2[ps] = *(const unsigned*)(row + grp * 64 + 32 + 2 * l16); }
#pragma unroll
        for (int ps = 0; ps < 8; ++ps) { const int grp = ps * 2 + g2; d1[ps] = *(const unsigned*)(rowD + grp * 128 + 2 * l32); d2[ps] = *(const unsigned*)(rowD + grp * 128 + 64 + 2 * l32); }
#pragma unroll
        for (int ps = 0; ps < 8; ++ps) { const int grp = ps * 4 + g4; nn[ps] = *(const u32x2*)(rowN + grp * 64 + 4 * l16); }
#pragma unroll
        for (int ps = 0; ps < 4; ++ps) { const int grp = ps * 4 + g4; const float sc = grp >= 8 ? 0.125f : 1.0f;
            const float a0 = lo_f(r1[ps]), a1 = hi_f(r1[ps]), b0 = lo_f(r2[ps]), b1 = hi_f(r2[ps]);
            *(unsigned*)(row + grp * 64 + 2 * l16) = pk2((a0 * c64a.x - b0 * c64a.y) * sc, (a1 * c64b.x - b1 * c64b.y) * sc);
            *(unsigned*)(row + grp * 64 + 32 + 2 * l16) = pk2((a0 * c64a.y + b0 * c64a.x) * sc, (a1 * c64b.y + b1 * c64b.x) * sc); }
#pragma unroll
        for (int ps = 0; ps < 8; ++ps) { const int grp = ps * 2 + g2; const bool isk = grp >= 8;
            float a0 = lo_f(d1[ps]), a1 = hi_f(d1[ps]), b0 = lo_f(d2[ps]), b1 = hi_f(d2[ps]);
            float ss = (a0 * a0 + a1 * a1) + (b0 * b0 + b1 * b1);
#pragma unroll
            for (int o = 1; o < 32; o <<= 1) ss += __shfl_xor(ss, o);
            const float rstd = rsqrtf(ss * (1.0f / 128.0f) + EPS);
            a0 *= rstd * (isk ? dk0 : dq0); a1 *= rstd * (isk ? dk1 : dq1); b0 *= rstd * (isk ? dk2 : dq2); b1 *= rstd * (isk ? dk3 : dq3);
            *(unsigned*)(rowD + grp * 128 + 2 * l32) = pk2(a0 * c128a.x - b0 * c128a.y, a1 * c128b.x - b1 * c128b.y);
            *(unsigned*)(rowD + grp * 128 + 64 + 2 * l32) = pk2(a0 * c128a.y + b0 * c128a.x, a1 * c128b.y + b1 * c128b.x); }
#pragma unroll
        for (int ps = 0; ps < 8; ++ps) { const int grp = ps * 4 + g4; const f32x4 gn = grp >= 16 ? nk4 : nq4;
            const float a0 = lo_f(nn[ps].x), a1 = hi_f(nn[ps].x), a2 = lo_f(nn[ps].y), a3 = hi_f(nn[ps].y);
            float ss = (a0 * a0 + a1 * a1) + (a2 * a2 + a3 * a3);
#pragma unroll
            for (int o = 1; o < 16; o <<= 1) ss += __shfl_xor(ss, o);
            const float rstd = rsqrtf(ss * (1.0f / 64.0f) + EPS);
            u32x2 o2; o2.x = pk2(a0 * rstd * gn.x, a1 * rstd * gn.y); o2.y = pk2(a2 * rstd * gn.z, a3 * rstd * gn.w);
            *(u32x2*)(rowN + grp * 64 + 4 * l16) = o2; }
    }
}

__device__ __forceinline__ int act_prev_row(int m) { if (m < RB) return (m & 15) > 0 ? m - 1 : -1; const int s = (m - RB) & (SEQ - 1), b = (m - RB) >> 11; return s > 0 ? m - 1 : b * 16 + 15; }
__device__ __forceinline__ int act_next_row(int m) { if (m < RB) return (m & 15) < 15 ? m + 1 : RB + (m >> 4) * SEQ; const int s = (m - RB) & (SEQ - 1); return s < SEQ - 1 ? m + 1 : -1; }
__device__ __forceinline__ void act_phase(ParamsCP pp, int layer, int gtid, int ngt) {
    const bf16_t* Gb = (const bf16_t*)(pp->ws + WS_BIG + BIG_G); bf16_t* Vb = (bf16_t*)(pp->ws + WS_BIG + BIG_V);
    const float* cw = pp->in[20] + (size_t)layer * 3 * DFF; const float* cb = pp->in[21] + (size_t)layer * DFF;
    constexpr int NCH = DFF / 8, NRB = M / 8;
    for (int i = gtid; i < NRB * NCH; i += ngt) {
        const int rb = i / NCH, ch = i - rb * NCH, c0 = ch * 8, m0 = rb * 8;
        const int mp = act_prev_row(m0), mn = act_next_row(m0 + 7);
        const u32x4 z = (u32x4){0u, 0u, 0u, 0u};
        u32x4 g[10], v[8];
        g[0] = mp >= 0 ? *(const u32x4*)(Gb + (size_t)mp * DFF + c0) : z;
#pragma unroll
        for (int r = 0; r < 8; ++r) { g[r + 1] = *(const u32x4*)(Gb + (size_t)(m0 + r) * DFF + c0); v[r] = *(const u32x4*)(Vb + (size_t)(m0 + r) * DFF + c0); }
        g[9] = mn >= 0 ? *(const u32x4*)(Gb + (size_t)mn * DFF + c0) : z;
        float w0[8], w1[8], w2[8], bb[8];
#pragma unroll
        for (int j = 0; j < 8; ++j) { w0[j] = cw[c0 + j]; w1[j] = cw[DFF + c0 + j]; w2[j] = cw[2 * DFF + c0 + j]; bb[j] = cb[c0 + j]; }
#pragma unroll
        for (int r = 0; r < 8; ++r) {
            const unsigned gp[4] = {g[r].x, g[r].y, g[r].z, g[r].w}, gc[4] = {g[r + 1].x, g[r + 1].y, g[r + 1].z, g[r + 1].w}, gn[4] = {g[r + 2].x, g[r + 2].y, g[r + 2].z, g[r + 2].w}, vv[4] = {v[r].x, v[r].y, v[r].z, v[r].w};
            float o[8];
#pragma unroll
            for (int j = 0; j < 4; ++j) {
                const float a0 = lo_f(gp[j]) * w0[2 * j] + lo_f(gc[j]) * w1[2 * j] + lo_f(gn[j]) * w2[2 * j] + bb[2 * j];
                const float a1 = hi_f(gp[j]) * w0[2 * j + 1] + hi_f(gc[j]) * w1[2 * j + 1] + hi_f(gn[j]) * w2[2 * j + 1] + bb[2 * j + 1];
                o[2 * j] = a0 * sigmoid_f(a0) * lo_f(vv[j]); o[2 * j + 1] = a1 * sigmoid_f(a1) * hi_f(vv[j]);
            }
            u32x4 w; w.x = pk2(o[0], o[1]); w.y = pk2(o[2], o[3]); w.z = pk2(o[4], o[5]); w.w = pk2(o[6], o[7]);
            *(u32x4*)(Vb + (size_t)(m0 + r) * DFF + c0) = w;
        }
    }
}

template <int KS>
__device__ __forceinline__ void load_k(bf16x8 (&kf)[KS], const bf16_t* kp) {
#pragma unroll
    for (int ks = 0; ks < KS; ++ks) kf[ks] = *(const bf16x8*)(kp + 32 * ks);
}
template <int KS>
__device__ __forceinline__ f32x4 st_mma(const bf16x8 (&kf)[KS], const bf16x8 (&qf)[KS]) {
    f32x4 s = (f32x4){0.f, 0.f, 0.f, 0.f};
#pragma unroll
    for (int ks = 0; ks < KS; ++ks) s = mfma16(kf[ks], qf[ks], s);
    return s;
}
__device__ __forceinline__ bf16x8 pack_p(const float (&p0)[4], const float (&p1)[4]) {
    u32x4 w; w.x = pk2(p0[0], p0[1]); w.y = pk2(p0[2], p0[3]); w.z = pk2(p1[0], p1[1]); w.w = pk2(p1[2], p1[3]);
    return __builtin_bit_cast(bf16x8, w);
}
template <int NT>
__device__ __forceinline__ void pv_step(f32x4 (&acc)[NT], bf16x8 pf, const bf16_t* v0, const bf16_t* v1) {
    constexpr int GRP = NT < 8 ? NT : 8;
#pragma unroll
    for (int g0 = 0; g0 < NT; g0 += GRP) {
        u32x2 va[GRP], vb[GRP];
#pragma unroll
        for (int i = 0; i < GRP; ++i) { va[i] = *(const u32x2*)(v0 + (size_t)(g0 + i) * 16 * M); vb[i] = *(const u32x2*)(v1 + (size_t)(g0 + i) * 16 * M); }
#pragma unroll
        for (int i = 0; i < GRP; ++i) asm volatile("" : "+v"(va[i]), "+v"(vb[i]));
#pragma unroll
        for (int i = 0; i < GRP; ++i) { u32x4 w; w.x = va[i].x; w.y = va[i].y; w.z = vb[i].x; w.w = vb[i].y; acc[g0 + i] = mfma16(pf, __builtin_bit_cast(bf16x8, w), acc[g0 + i]); }
    }
}

constexpr int MX_KBYTES = 32 * 272, MX_VBYTES = 256 * 80, MX_BUF = MX_KBYTES + MX_VBYTES, MX_FLAG = 2 * MX_BUF;
constexpr size_t BIG_RO = BIG_VT + (size_t)NVT * M * 2;
static_assert(BIG_RO + (size_t)M * 1024 * 2 <= BIG_BYTES, "RO fits");
static_assert(MX_FLAG + 64 <= 131072, "mixer LDS fits");
template <int DK, int DV, bool DIFF>
__device__ __forceinline__ void wg_attn_task(ParamsCP pp, int layer, LAS unsigned char* lds, int b, int h, int qb, int tid) {
    constexpr int KS = DK / 32, NT = DV / 16, KP = DK * 2 + 16, VP = 80, KCH = DK / 8, NV = (DV * 4 + 511) / 512;
    const bf16_t* PROJ = (const bf16_t*)(pp->ws + WS_BIG + BIG_PROJ); const bf16_t* VT = (const bf16_t*)(pp->ws + WS_BIG + BIG_VT);
    const int lane = tid & 63, wave = __builtin_amdgcn_readfirstlane(tid >> 6), c16 = lane & 15, quad = lane >> 4;
    const size_t qcol = DIFF ? PBUF + h * 256 : (size_t)(C_RQ + h * 64);
    const size_t kcol = DIFF ? PBUF + 1024 + h * 256 : (size_t)(C_RK + h * 64);
    const int vrow0 = DIFF ? V_DIFF + h * 256 : V_RET + h * 128;
    const int jraw = qb * 8 + wave; const bool active = jraw < 129; const int jq = active ? jraw : 128;
    const int qrow0 = tile_row(b, jq);
    const bool kcopy = tid < 32 * KCH; const int krow = tid / KCH, kch = tid % KCH;
    float lam = 0.f, cb = 0.f; float lgf = 0.f, lgb = 0.f;
    if (DIFF) { const float* misc = (const float*)(pp->ws + WS_MISC) + 16 * layer; lam = misc[0]; cb = misc[1] * LOG2E; }
    else { lgf = log1pf(-exp2f(-pp->in[4][layer * 8 + h])) * LOG2E; lgb = log1pf(-exp2f(-pp->in[5][layer * 8 + h])) * LOG2E; }
    const float sc = 0.08838834764831845f * LOG2E;
    const int tq = 16 * jq + c16;
    f32x4 O[NT];
#pragma unroll
    for (int e0 = 0; e0 < NT; ++e0) O[e0] = (f32x4){0.f, 0.f, 0.f, 0.f};
#pragma unroll 1
    for (int half = 0; half < (DIFF ? 2 : 1); ++half) {
        bf16x8 qf[KS];
        { const bf16_t* qp = PROJ + (size_t)(qrow0 + c16) * PP + qcol + half * 128 + 8 * quad;
#pragma unroll
            for (int ks = 0; ks < KS; ++ks) qf[ks] = *(const bf16x8*)(qp + 32 * ks); }
        f32x4 acc[NT];
#pragma unroll
        for (int e0 = 0; e0 < NT; ++e0) acc[e0] = (f32x4){0.f, 0.f, 0.f, 0.f};
        float lsum = 0.f;
        const size_t kc = kcol + half * 128 + kch * 8;
        u32x4 kreg = (u32x4){0u, 0u, 0u, 0u}, vreg[NV];
#define MX_ISSUE(step) do { const int jt0_ = 2 * (step), jt1_ = jt0_ + 1 < 129 ? jt0_ + 1 : 128; const int kr0_ = tile_row(b, jt0_), kr1_ = tile_row(b, jt1_); \
            if (kcopy) kreg = *(const u32x4*)(PROJ + (size_t)(krow < 16 ? kr0_ + krow : kr1_ + krow - 16) * PP + kc); \
            _Pragma("unroll") for (int i_ = 0; i_ < NV; ++i_) { const int id_ = tid + 512 * i_, vr_ = id_ >> 2, vc_ = id_ & 3; \
                vreg[i_] = *(const u32x4*)(VT + (size_t)(vrow0 + vr_) * M + ((vc_ < 2 ? kr0_ : kr1_) + (vc_ & 1) * 8)); } } while (0)
#define MX_COMMIT(buf) do { LAS unsigned char* bb_ = lds + (buf) * MX_BUF; \
            if (kcopy) *(LAS u32x4*)(bb_ + krow * KP + kch * 16) = kreg; \
            _Pragma("unroll") for (int i_ = 0; i_ < NV; ++i_) { const int id_ = tid + 512 * i_, vr_ = id_ >> 2, vc_ = id_ & 3; \
                *(LAS u32x4*)(bb_ + MX_KBYTES + vr_ * VP + vc_ * 16) = vreg[i_]; } } while (0)
        __syncthreads();
        MX_ISSUE(0); MX_COMMIT(0);
        __syncthreads();
#pragma unroll 1
        for (int st = 0; st < 65; ++st) {
            const int buf = st & 1;
            if (st + 1 < 65) MX_ISSUE(st + 1);
            const LAS unsigned char* kb = lds + buf * MX_BUF; const LAS unsigned char* vb = kb + MX_KBYTES;
            bf16x8 k0[KS], k1[KS];
#pragma unroll
            for (int ks = 0; ks < KS; ++ks) { k0[ks] = *(const LAS bf16x8*)(kb + c16 * KP + (32 * ks + 8 * quad) * 2); k1[ks] = *(const LAS bf16x8*)(kb + (16 + c16) * KP + (32 * ks + 8 * quad) * 2); }
            const f32x4 s0 = st_mma<KS>(k0, qf), s1 = st_mma<KS>(k1, qf);
            const bool v1 = 2 * st + 1 < 129;
            float p0[4], p1[4];
#pragma unroll
            for (int r = 0; r < 4; ++r) {
                if (DIFF) { p0[r] = fast_exp2(s0[r] * sc - cb); p1[r] = v1 ? fast_exp2(s1[r] * sc - cb) : 0.f; lsum += p0[r] + p1[r]; }
                else { const int d0 = tq - (32 * st + 4 * quad + r), d1 = d0 - 16;
                    p0[r] = s0[r] * fast_exp2(d0 >= 0 ? (float)d0 * lgf : (float)(-d0) * lgb);
                    p1[r] = v1 ? s1[r] * fast_exp2(d1 >= 0 ? (float)d1 * lgf : (float)(-d1) * lgb) : 0.f; }
            }
            const bf16x8 pf = pack_p(p0, p1);
#pragma unroll
            for (int e0 = 0; e0 < NT; ++e0) {
                const u32x2 va = *(const LAS u32x2*)(vb + (e0 * 16 + c16) * VP + 8 * quad), vbb = *(const LAS u32x2*)(vb + (e0 * 16 + c16) * VP + 32 + 8 * quad);
                u32x4 w; w.x = va.x; w.y = va.y; w.z = vbb.x; w.w = vbb.y;
                acc[e0] = mfma16(pf, __builtin_bit_cast(bf16x8, w), acc[e0]);
            }
            if (st + 1 < 65) MX_COMMIT(buf ^ 1);
            __syncthreads();
        }
#undef MX_ISSUE
#undef MX_COMMIT
        if (DIFF) {
            lsum += __shfl_xor(lsum, 16); lsum += __shfl_xor(lsum, 32);
            float il[4];
#pragma unroll
            for (int r = 0; r < 4; ++r) il[r] = 1.0f / __shfl(lsum, 4 * quad + r);
            const float f = half == 0 ? 1.0f : -lam;
#pragma unroll
            for (int e0 = 0; e0 < NT; ++e0)
#pragma unroll
                for (int r = 0; r < 4; ++r) O[e0][r] += f * acc[e0][r] * il[r];
        } else {
#pragma unroll
            for (int e0 = 0; e0 < NT; ++e0) O[e0] = acc[e0];
        }
    }
    if (active) {
        bf16_t* yb = DIFF ? (bf16_t*)(pp->ws + WS_BIG + BIG_PROJ) + PBUF + (size_t)(qrow0 + 4 * quad) * PP + h * 256 + c16
                          : (bf16_t*)(pp->ws + WS_BIG + BIG_RO) + (size_t)(qrow0 + 4 * quad) * 1024 + h * 128 + c16;
        const int pitch = DIFF ? PP : 1024;
#pragma unroll
        for (int e0 = 0; e0 < NT; ++e0)
#pragma unroll
            for (int r = 0; r < 4; ++r) yb[(size_t)r * pitch + e0 * 16] = (bf16_t)f2bf(O[e0][r]);
    }
}
constexpr int DF_KP = 528, DF_KBYTES = 32 * DF_KP, DF_BUF = DF_KBYTES + MX_VBYTES;
static_assert(2 * DF_BUF <= MX_FLAG || 2 * DF_BUF + 64 <= 131072, "diff LDS");
constexpr int DF_FLAG = 2 * DF_BUF;
__device__ __forceinline__ void wg_diff_task(ParamsCP pp, int layer, LAS unsigned char* lds, int b, int h, int qb, int tid_in) {
    constexpr int VP = 80;
    int tid = tid_in; asm volatile("" : "+v"(tid));
    const bf16_t* PROJ = (const bf16_t*)(pp->ws + WS_BIG + BIG_PROJ); const bf16_t* VT = (const bf16_t*)(pp->ws + WS_BIG + BIG_VT);
    const int lane = tid & 63, wave = __builtin_amdgcn_readfirstlane(tid >> 6), c16 = lane & 15, quad = lane >> 4;
    const size_t qcol = PBUF + h * 256, kcol = PBUF + 1024 + h * 256;
    const int vrow0 = V_DIFF + h * 256;
    const int jraw = qb * 8 + wave; const bool active = jraw < 129; const int jq = active ? jraw : 128;
    const int qrow0 = tile_row(b, jq);
    const float* misc = (const float*)(pp->ws + WS_MISC) + 16 * layer;
    const float lam = uniform_f(misc[0]), cb = uniform_f(misc[1] * LOG2E), sc = 0.08838834764831845f * LOG2E;
    bf16x8 qf0[4], qf1[4];
    { const bf16_t* qp = PROJ + (size_t)(qrow0 + c16) * PP + qcol + 8 * quad;
#pragma unroll
        for (int ks = 0; ks < 4; ++ks) { qf0[ks] = *(const bf16x8*)(qp + 32 * ks); qf1[ks] = *(const bf16x8*)(qp + 128 + 32 * ks); } }
    f32x4 acc0[16], acc1[16];
#pragma unroll
    for (int e0 = 0; e0 < 16; ++e0) { acc0[e0] = (f32x4){0.f, 0.f, 0.f, 0.f}; acc1[e0] = (f32x4){0.f, 0.f, 0.f, 0.f}; }
    float ls0 = 0.f, ls1 = 0.f;
    u32x4 kreg[2], vreg[2];
#define DF_ISSUE(step) do { const int jt0_ = 2 * (step), jt1_ = jt0_ + 1 < 129 ? jt0_ + 1 : 128; const int kr0_ = tile_row(b, jt0_), kr1_ = tile_row(b, jt1_); \
        _Pragma("unroll") for (int i_ = 0; i_ < 2; ++i_) { const int id_ = tid + 512 * i_, kr_ = id_ >> 5, kc_ = id_ & 31, vr_ = id_ >> 2, vc_ = id_ & 3; \
            kreg[i_] = *(const u32x4*)(PROJ + (size_t)(kr_ < 16 ? kr0_ + kr_ : kr1_ + kr_ - 16) * PP + kcol + kc_ * 8); \
            vreg[i_] = *(const u32x4*)(VT + (size_t)(vrow0 + vr_) * M + ((vc_ < 2 ? kr0_ : kr1_) + (vc_ & 1) * 8)); } } while (0)
#define DF_COMMIT(buf) do { LAS unsigned char* bb_ = lds + (buf) * DF_BUF; \
        _Pragma("unroll") for (int i_ = 0; i_ < 2; ++i_) { const int id_ = tid + 512 * i_, kr_ = id_ >> 5, kc_ = id_ & 31, vr_ = id_ >> 2, vc_ = id_ & 3; \
            *(LAS u32x4*)(bb_ + kr_ * DF_KP + kc_ * 16) = kreg[i_]; *(LAS u32x4*)(bb_ + DF_KBYTES + vr_ * VP + vc_ * 16) = vreg[i_]; } } while (0)
    __syncthreads();
    DF_ISSUE(0); DF_COMMIT(0);
    __syncthreads();
#pragma unroll 1
    for (int st = 0; st < 65; ++st) {
        const int buf = st & 1;
        if (st + 1 < 65) DF_ISSUE(st + 1);
        const LAS unsigned char* kb = lds + buf * DF_BUF; const LAS unsigned char* vb = kb + DF_KBYTES;
        const bool v1 = 2 * st + 1 < 129;
        bf16x8 pf0, pf1;
        {   bf16x8 k0[4], k1[4];
#pragma unroll
            for (int ks = 0; ks < 4; ++ks) { k0[ks] = *(const LAS bf16x8*)(kb + c16 * DF_KP + (32 * ks + 8 * quad) * 2); k1[ks] = *(const LAS bf16x8*)(kb + (16 + c16) * DF_KP + (32 * ks + 8 * quad) * 2); }
            const f32x4 s0 = st_mma<4>(k0, qf0), s1 = st_mma<4>(k1, qf0);
            float p0[4], p1[4];
#pragma unroll
            for (int r = 0; r < 4; ++r) { p0[r] = fast_exp2(s0[r] * sc - cb); p1[r] = v1 ? fast_exp2(s1[r] * sc - cb) : 0.f; ls0 += p0[r] + p1[r]; }
            pf0 = pack_p(p0, p1); }
        {   bf16x8 k0[4], k1[4];
#pragma unroll
            for (int ks = 0; ks < 4; ++ks) { k0[ks] = *(const LAS bf16x8*)(kb + c16 * DF_KP + 256 + (32 * ks + 8 * quad) * 2); k1[ks] = *(const LAS bf16x8*)(kb + (16 + c16) * DF_KP + 256 + (32 * ks + 8 * quad) * 2); }
            const f32x4 s0 = st_mma<4>(k0, qf1), s1 = st_mma<4>(k1, qf1);
            float p0[4], p1[4];
#pragma unroll
            for (int r = 0; r < 4; ++r) { p0[r] = fast_exp2(s0[r] * sc - cb); p1[r] = v1 ? fast_exp2(s1[r] * sc - cb) : 0.f; ls1 += p0[r] + p1[r]; }
            pf1 = pack_p(p0, p1); }
#pragma unroll
        for (int e0 = 0; e0 < 16; ++e0) {
            const u32x2 va = *(const LAS u32x2*)(vb + (e0 * 16 + c16) * VP + 8 * quad), vbb = *(const LAS u32x2*)(vb + (e0 * 16 + c16) * VP + 32 + 8 * quad);
            u32x4 w; w.x = va.x; w.y = va.y; w.z = vbb.x; w.w = vbb.y; const bf16x8 vf = __builtin_bit_cast(bf16x8, w);
            acc0[e0] = mfma16(pf0, vf, acc0[e0]); acc1[e0] = mfma16(pf1, vf, acc1[e0]);
        }
        if (st + 1 < 65) DF_COMMIT(buf ^ 1);
        __syncthreads();
    }
#undef DF_ISSUE
#undef DF_COMMIT
    ls0 += __shfl_xor(ls0, 16); ls0 += __shfl_xor(ls0, 32); ls1 += __shfl_xor(ls1, 16); ls1 += __shfl_xor(ls1, 32);
    float i0[4], i1[4];
#pragma unroll
    for (int r = 0; r < 4; ++r) { i0[r] = fast_rcp(__shfl(ls0, 4 * quad + r)); i1[r] = lam * fast_rcp(__shfl(ls1, 4 * quad + r)); }
    if (active) {
        bf16_t* yb = (bf16_t*)(pp->ws + WS_BIG + BIG_PROJ) + PBUF + (size_t)(qrow0 + 4 * quad) * PP + h * 256 + c16;
#pragma unroll
        for (int e0 = 0; e0 < 16; ++e0)
#pragma unroll
            for (int r = 0; r < 4; ++r) yb[(size_t)r * PP + e0 * 16] = (bf16_t)f2bf(acc0[e0][r] * i0[r] - acc1[e0][r] * i1[r]);
    }
}
__device__ __forceinline__ void diff_post_phase(ParamsCP pp, int layer, int gw, int ngw, int lane) {
    bf16_t* PD = (bf16_t*)(pp->ws + WS_BIG + BIG_PROJ) + PBUF;
    const float* misc = (const float*)(pp->ws + WS_MISC) + 16 * layer;
    const float cl = 1.0f - misc[3];
    const float* og = pp->in[10] + layer * 256;
    const f32x4 g4 = *(const f32x4*)(og + 4 * lane);
    for (int m = gw; m < M; m += ngw) {
        u32x2 w[4];
#pragma unroll
        for (int h = 0; h < 4; ++h) w[h] = *(const u32x2*)(PD + (size_t)m * PP + h * 256 + 4 * lane);
#pragma unroll
        for (int h = 0; h < 4; ++h) {
            const float a0 = lo_f(w[h].x), a1 = hi_f(w[h].x), a2 = lo_f(w[h].y), a3 = hi_f(w[h].y);
            const float ss = wave_sum((a0 * a0 + a1 * a1) + (a2 * a2 + a3 * a3));
            const float rs = rsqrtf(ss * (1.0f / 256.0f) + EPS) * cl;
            u32x2 o2; o2.x = pk2(a0 * rs * g4.x, a1 * rs * g4.y); o2.y = pk2(a2 * rs * g4.z, a3 * rs * g4.w);
            *(u32x2*)(PD + (size_t)m * PP + h * 256 + 4 * lane) = o2;
        }
    }
}
__device__ __forceinline__ void wg_ret_task(ParamsCP pp, int layer, LAS unsigned char* lds, int b, int h, int qb, int tid_in) {
    constexpr int KP = 144, VP = 80;
    int tid = tid_in; asm volatile("" : "+v"(tid));
    const bf16_t* PROJ = (const bf16_t*)(pp->ws + WS_BIG + BIG_PROJ); const bf16_t* VT = (const bf16_t*)(pp->ws + WS_BIG + BIG_VT);
    const int lane = tid & 63, wave = __builtin_amdgcn_readfirstlane(tid >> 6), c16 = lane & 15, quad = lane >> 4;
    const size_t qcol = C_RQ + h * 64, kcol = C_RK + h * 64;
    const int vrow0 = V_RET + h * 128;
    const int jrA = qb * 16 + wave, jrB = jrA + 8; const bool actA = jrA < 129, actB = jrB < 129; const int jA = actA ? jrA : 128, jB = actB ? jrB : 128;
    const int qrowA = tile_row(b, jA), qrowB = tile_row(b, jB);
    const bool kcopy = tid < 256; const int krow = (tid & 255) >> 3, kch = tid & 7, vr = tid >> 2, vc = tid & 3;
    const float lgf = log1pf(-exp2f(-pp->in[4][layer * 8 + h])) * LOG2E, lgb = log1pf(-exp2f(-pp->in[5][layer * 8 + h])) * LOG2E;
    const int tqA = 16 * jA + c16, tqB = 16 * jB + c16;
    bf16x8 qA[2], qB[2];
    { const bf16_t* qp = PROJ + (size_t)(qrowA + c16) * PP + qcol + 8 * quad; qA[0] = *(const bf16x8*)qp; qA[1] = *(const bf16x8*)(qp + 32);
      const bf16_t* qp2 = PROJ + (size_t)(qrowB + c16) * PP + qcol + 8 * quad; qB[0] = *(const bf16x8*)qp2; qB[1] = *(const bf16x8*)(qp2 + 32); }
    f32x4 accA[8], accB[8];
#pragma unroll
    for (int e0 = 0; e0 < 8; ++e0) { accA[e0] = (f32x4){0.f, 0.f, 0.f, 0.f}; accB[e0] = (f32x4){0.f, 0.f, 0.f, 0.f}; }
    u32x4 kr0s = (u32x4){0u, 0u, 0u, 0u}, vr0s = kr0s, kr1s = kr0s, vr1s = kr0s;
#define RT_ISSUE(KR, VR, step) do { const int s_ = (step) < 65 ? (step) : 64; const int jt0_ = 2 * s_, jt1_ = jt0_ + 1 < 129 ? jt0_ + 1 : 128; const int a0_ = tile_row(b, jt0_), a1_ = tile_row(b, jt1_); \
        if (kcopy) KR = *(const u32x4*)(PROJ + (size_t)(krow < 16 ? a0_ + krow : a1_ + krow - 16) * PP + kcol + kch * 8); \
        VR = *(const u32x4*)(VT + (size_t)(vrow0 + vr) * M + ((vc < 2 ? a0_ : a1_) + (vc & 1) * 8)); } while (0)
#define RT_COMMIT(KR, VR, buf) do { LAS unsigned char* bb_ = lds + (buf) * MX_BUF; \
        if (kcopy) *(LAS u32x4*)(bb_ + krow * KP + kch * 16) = KR; *(LAS u32x4*)(bb_ + MX_KBYTES + vr * VP + vc * 16) = VR; } while (0)
#define RT_COMPUTE(st, buf) do { const LAS unsigned char* kb = lds + (buf) * MX_BUF; const LAS unsigned char* vb = kb + MX_KBYTES; \
        bf16x8 k0[2], k1[2]; \
        _Pragma("unroll") for (int ks = 0; ks < 2; ++ks) { k0[ks] = *(const LAS bf16x8*)(kb + c16 * KP + (32 * ks + 8 * quad) * 2); k1[ks] = *(const LAS bf16x8*)(kb + (16 + c16) * KP + (32 * ks + 8 * quad) * 2); } \
        const f32x4 sA0 = st_mma<2>(k0, qA), sA1 = st_mma<2>(k1, qA), sB0 = st_mma<2>(k0, qB), sB1 = st_mma<2>(k1, qB); \
        const bool v1 = 2 * (st) + 1 < 129; float pa0[4], pa1[4], pb0[4], pb1[4]; \
        _Pragma("unroll") for (int r = 0; r < 4; ++r) { const int tk = 32 * (st) + 4 * quad + r; \
            const int dA0 = tqA - tk, dA1 = dA0 - 16, dB0 = tqB - tk, dB1 = dB0 - 16; \
            pa0[r] = sA0[r] * fast_exp2(dA0 >= 0 ? (float)dA0 * lgf : (float)(-dA0) * lgb); \
            pa1[r] = v1 ? sA1[r] * fast_exp2(dA1 >= 0 ? (float)dA1 * lgf : (float)(-dA1) * lgb) : 0.f; \
            pb0[r] = sB0[r] * fast_exp2(dB0 >= 0 ? (float)dB0 * lgf : (float)(-dB0) * lgb); \
            pb1[r] = v1 ? sB1[r] * fast_exp2(dB1 >= 0 ? (float)dB1 * lgf : (float)(-dB1) * lgb) : 0.f; } \
        const bf16x8 pfA = pack_p(pa0, pa1), pfB = pack_p(pb0, pb1); \
        _Pragma("unroll") for (int e0 = 0; e0 < 8; ++e0) { \
            const u32x2 va = *(const LAS u32x2*)(vb + (e0 * 16 + c16) * VP + 8 * quad), vbb = *(const LAS u32x2*)(vb + (e0 * 16 + c16) * VP + 32 + 8 * quad); \
            u32x4 w; w.x = va.x; w.y = va.y; w.z = vbb.x; w.w = vbb.y; const bf16x8 vf = __builtin_bit_cast(bf16x8, w); \
            accA[e0] = mfma16(pfA, vf, accA[e0]); accB[e0] = mfma16(pfB, vf, accB[e0]); } } while (0)
    __syncthreads();
    RT_ISSUE(kr0s, vr0s, 0); RT_COMMIT(kr0s, vr0s, 0); RT_ISSUE(kr1s, vr1s, 1);
    __syncthreads();
#pragma unroll 1
    for (int st = 0; st < 65; st += 2) {
        RT_ISSUE(kr0s, vr0s, st + 2); RT_COMPUTE(st, 0); RT_COMMIT(kr1s, vr1s, 1); __syncthreads();
        if (st + 1 < 65) { RT_ISSUE(kr1s, vr1s, st + 3); RT_COMPUTE(st + 1, 1); RT_COMMIT(kr0s, vr0s, 0); __syncthreads(); }
    }
#undef RT_ISSUE
#undef RT_COMMIT
#undef RT_COMPUTE
    bf16_t* ro = (bf16_t*)(pp->ws + WS_BIG + BIG_RO);
    if (actA) { bf16_t* yb = ro + (size_t)(qrowA + 4 * quad) * 1024 + h * 128 + c16;
#pragma unroll
        for (int e0 = 0; e0 < 8; ++e0)
#pragma unroll
            for (int r = 0; r < 4; ++r) yb[(size_t)r * 1024 + e0 * 16] = (bf16_t)f2bf(accA[e0][r]); }
    if (actB) { bf16_t* yb = ro + (size_t)(qrowB + 4 * quad) * 1024 + h * 128 + c16;
#pragma unroll
        for (int e0 = 0; e0 < 8; ++e0)
#pragma unroll
            for (int r = 0; r < 4; ++r) yb[(size_t)r * 1024 + e0 * 16] = (bf16_t)f2bf(accB[e0][r]); }
}
__device__ __forceinline__ void ret_post_phase(ParamsCP pp, int layer, int gw, int ngw, int lane) {
    bf16_t* PR = (bf16_t*)(pp->ws + WS_BIG + BIG_PROJ); const bf16_t* RO = (const bf16_t*)(pp->ws + WS_BIG + BIG_RO);
    const float* og = pp->in[6] + layer * 1024;
    float o0[8], o1[8];
#pragma unroll
    for (int h = 0; h < 8; ++h) { o0[h] = og[h * 128 + 2 * lane]; o1[h] = og[h * 128 + 2 * lane + 1]; }
    for (int m = gw; m < M; m += ngw) {
        unsigned w[8], gv[8];
#pragma unroll
        for (int h = 0; h < 8; ++h) { w[h] = *(const unsigned*)(RO + (size_t)m * 1024 + h * 128 + 2 * lane); gv[h] = *(const unsigned*)(PR + (size_t)m * PP + C_RG + h * 128 + 2 * lane); }
#pragma unroll
        for (int h = 0; h < 8; ++h) {
            const float a0 = lo_f(w[h]), a1 = hi_f(w[h]), g0 = lo_f(gv[h]), g1 = hi_f(gv[h]);
            const float ss = wave_sum(a0 * a0 + a1 * a1);
            const float rs = rsqrtf(ss * (1.0f / 128.0f) + EPS);
            *(unsigned*)(PR + (size_t)m * PP + C_RG + h * 128 + 2 * lane) = pk2(a0 * rs * o0[h] * g0 * sigmoid_f(g0), a1 * rs * o1[h] * g1 * sigmoid_f(g1));
        }
    }
}

__device__ __forceinline__ void na_task(ParamsCP pp, int layer, int b, int h, int r, int g, int lane_in) {
    int lane = lane_in; asm volatile("" : "+v"(lane));
    const bf16_t* PROJ = (const bf16_t*)(pp->ws + WS_BIG + BIG_PROJ); const bf16_t* VT = (const bf16_t*)(pp->ws + WS_BIG + BIG_VT);
    const float* misc = (const float*)(pp->ws + WS_MISC) + 16 * layer;
    const float bound = misc[2];
    const float* rpb = pp->in[13] + (size_t)layer * 7440 + (size_t)h * 465;
    const int c16 = lane & 15, quad = lane >> 4;
    const bool meta = r < 0;
    const int qrow0 = meta ? b * 16 : RB + b * SEQ + r * 64 + 16 * g;
    bf16x8 qf[2];
    { const bf16_t* qp = PROJ + 2 * PBUF + (size_t)(qrow0 + c16) * PP + h * 64 + 8 * quad; qf[0] = *(const bf16x8*)qp; qf[1] = *(const bf16x8*)(qp + 32); }
    f32x4 acc[4];
#pragma unroll
    for (int e0 = 0; e0 < 4; ++e0) acc[e0] = (f32x4){0.f, 0.f, 0.f, 0.f};
    float lsum = 0.f;
    const size_t colk = 2 * PBUF + 1024 + h * 64 + 8 * quad;
    const bf16_t* vbase = VT + (size_t)(V_NA + h * 64 + c16) * M + 4 * quad;
    const int qc = 16 * g + c16;
    int cstart = qc - 8; cstart = cstart < 0 ? 0 : (cstart > 48 ? 48 : cstart);
    int rs = r - 4; rs = rs < 0 ? 0 : (rs > 24 ? 24 : rs);
    int cw0 = 16 * g - 8; cw0 = cw0 < 0 ? 0 : (cw0 > 32 ? 32 : cw0);
    int bi0[4], bi1[4]; bool ok0[4], ok1[4];
#pragma unroll
    for (int rr = 0; rr < 4; ++rr) { const int kc0 = cw0 + 4 * quad + rr, kc1 = kc0 + 16;
        int i0 = kc0 - qc + 15; i0 = i0 < 0 ? 0 : (i0 > 30 ? 30 : i0); int i1 = kc1 - qc + 15; i1 = i1 < 0 ? 0 : (i1 > 30 ? 30 : i1);
        bi0[rr] = i0; bi1[rr] = i1; ok0[rr] = kc0 >= cstart && kc0 < cstart + 16; ok1[rr] = kc1 >= cstart && kc1 < cstart + 16; }
    bf16x8 ck0[2], ck1[2], nk0[2], nk1[2]; u32x2 cva[4], cvb[4], nva[4], nvb[4]; float cb0[4], cb1[4], nb0[4], nb1[4];
#define NA_LOAD(K0, K1, VA, VB, B0, B1, s_) do { const bool win_ = (s_) < 8; const int kr0_ = win_ ? RB + b * SEQ + (rs + (s_)) * 64 + cw0 : b * 16; const int kr1_ = win_ ? kr0_ + 16 : kr0_; \
        load_k<2>(K0, PROJ + (size_t)(kr0_ + c16) * PP + colk); load_k<2>(K1, PROJ + (size_t)(kr1_ + c16) * PP + colk); \
        _Pragma("unroll") for (int e_ = 0; e_ < 4; ++e_) { VA[e_] = *(const u32x2*)(vbase + kr0_ + (size_t)e_ * 16 * M); VB[e_] = *(const u32x2*)(vbase + kr1_ + (size_t)e_ * 16 * M); } \
        const float* brow_ = rpb + (win_ ? (rs + (s_) - r + 7) * 31 : 0); \
        _Pragma("unroll") for (int rr_ = 0; rr_ < 4; ++rr_) { B0[rr_] = brow_[bi0[rr_]]; B1[rr_] = brow_[bi1[rr_]]; } } while (0)
    const int sfirst = meta ? 8 : 0;
    NA_LOAD(ck0, ck1, cva, cvb, cb0, cb1, sfirst);
#pragma unroll 1
    for (int s = sfirst; s < 9; ++s) {
        const bool win = s < 8;
        if (s + 1 < 9) NA_LOAD(nk0, nk1, nva, nvb, nb0, nb1, s + 1);
        asm volatile("" ::: "memory");
        const f32x4 s0 = st_mma<2>(ck0, qf), s1 = st_mma<2>(ck1, qf);
        float p0[4], p1[4];
#pragma unroll
        for (int rr = 0; rr < 4; ++rr) {
            if (win) { p0[rr] = ok0[rr] ? fast_exp2((s0[rr] * 0.125f + cb0[rr] - bound) * LOG2E) : 0.f; p1[rr] = ok1[rr] ? fast_exp2((s1[rr] * 0.125f + cb1[rr] - bound) * LOG2E) : 0.f; }
            else { p0[rr] = fast_exp2((s0[rr] * 0.125f - bound) * LOG2E); p1[rr] = 0.f; }
            lsum += p0[rr] + p1[rr];
        }
        const bf16x8 pf = pack_p(p0, p1);
#pragma unroll
        for (int e0 = 0; e0 < 4; ++e0) { u32x4 w; w.x = cva[e0].x; w.y = cva[e0].y; w.z = cvb[e0].x; w.w = cvb[e0].y; acc[e0] = mfma16(pf, __builtin_bit_cast(bf16x8, w), acc[e0]); }
#pragma unroll
        for (int i = 0; i < 2; ++i) { ck0[i] = nk0[i]; ck1[i] = nk1[i]; }
#pragma unroll
        for (int i = 0; i < 4; ++i) { cva[i] = nva[i]; cvb[i] = nvb[i]; cb0[i] = nb0[i]; cb1[i] = nb1[i]; }
    }
#undef NA_LOAD
    lsum += __shfl_xor(lsum, 16); lsum += __shfl_xor(lsum, 32);
    float il[4];
#pragma unroll
    for (int rr = 0; rr < 4; ++rr) il[rr] = 1.0f / __shfl(lsum, 4 * quad + rr);
    bf16_t* yb = (bf16_t*)(pp->ws + WS_BIG + BIG_PROJ) + 2 * PBUF + (size_t)(qrow0 + 4 * quad) * PP + h * 64 + c16;
#pragma unroll
    for (int e0 = 0; e0 < 4; ++e0)
#pragma unroll
        for (int rr = 0; rr < 4; ++rr) yb[(size_t)rr * PP + e0 * 16] = (bf16_t)f2bf(acc[e0][rr] * il[rr]);
}

constexpr int TW_DIFF = NBATCH * 4 * 17, TW_RET = NBATCH * 8 * 9, TW_TOTAL = TW_DIFF + TW_RET;
constexpr int T_NA = NBATCH * 16 * 128, T_NAM = NBATCH * 16, T_NATOTAL = T_NA + T_NAM;
__device__ __forceinline__ void mixer_phase(ParamsCP pp, int layer, LAS unsigned char* lds, int tid) {
    unsigned* ctrw = (unsigned*)(pp->ws + WS_CTL) + 64 * layer; unsigned* ctrn = ctrw + 128;
    const int lane = tid & 63;
    LAS unsigned* flag = (LAS unsigned*)(lds + DF_FLAG);
    for (;;) {
        __syncthreads();
        if (tid == 0) *flag = atomicAdd(ctrw, 1u);
        __syncthreads();
        const int q = (int)__builtin_amdgcn_readfirstlane((int)*flag);
        if (q >= TW_TOTAL) break;
        if (q < TW_DIFF) { const int b = q / 68, rem = q - b * 68, h = rem / 17, qb = rem - h * 17; wg_diff_task(pp, layer, lds, b, h, qb, tid); }
        else { const int q2 = q - TW_DIFF; const int b = q2 / 72, rem = q2 - b * 72, h = rem / 9, qb = rem - h * 9; wg_ret_task(pp, layer, lds, b, h, qb, tid); }
    }
    for (;;) {
        unsigned t = 0;
        if (lane == 0) t = atomicAdd(ctrn, 1u);
        t = (unsigned)__builtin_amdgcn_readfirstlane((int)t);
        if (t >= (unsigned)T_NATOTAL) break;
        int q = (int)t;
        if (q < T_NA) { const int b = q >> 11, rem = q & 2047, h = rem >> 7, rg = rem & 127; na_task(pp, layer, b, h, rg >> 2, rg & 3, lane); continue; }
        q -= T_NA;
        na_task(pp, layer, q >> 4, q & 15, -1, 0, lane);
    }
}

#define XB_TMO      128
#define XB_XCNT(j)  (256  + 64 * (j))
#define XB_XSUB(j)  (1280 + 64 * (j))
#define XB_XGEN(j)  (2304 + 64 * (j))
#define XB_TOP      3328
#define XB_TOPGEN   3392
#define XCD_BAR_WORDS 3456
#define XB_SPIN_CAP (1u << 18)
constexpr int CW_BAR = 1024;
static_assert((CW_BAR + XCD_BAR_WORDS) * 4 <= (int)CTL_BYTES, "barrier words inside the memset region");
__device__ __forceinline__ unsigned xb_ld(unsigned* p)              { return __hip_atomic_load(p, __ATOMIC_RELAXED, __HIP_MEMORY_SCOPE_AGENT); }
__device__ __forceinline__ unsigned xb_add(unsigned* p, unsigned v) { return __hip_atomic_fetch_add(p, v, __ATOMIC_RELAXED, __HIP_MEMORY_SCOPE_AGENT); }
__device__ __forceinline__ unsigned xb_xcc_id() { return (unsigned)__builtin_amdgcn_s_getreg((3 << 11) | 20) & 0xFu; }
#define XB_SPIN(cond, bar) do { unsigned _sp = 0; while (cond) { __builtin_amdgcn_s_sleep(1); \
    if ((++_sp & 255u) == 0u) { if (xb_ld(&(bar)[XB_TMO])) break; if (_sp > XB_SPIN_CAP) { atomicAdd(&(bar)[XB_TMO], 1u); break; } } } } while (0)
struct XcdBarrier { unsigned* bar; unsigned x; volatile LAS unsigned* st; };
__device__ __forceinline__ XcdBarrier xcd_barrier_post(unsigned* bar, volatile LAS unsigned* st) {
    XcdBarrier b; b.bar = bar; b.x = xb_xcc_id(); b.st = st;
    if (threadIdx.x == 0) (void)xb_add(&bar[XB_XCNT(b.x)], 1u);
    return b;
}
__device__ __forceinline__ void xcd_barrier_complete(unsigned* bar, unsigned x, unsigned& nloc, unsigned& nx) {
    const unsigned G = gridDim.x * gridDim.y * gridDim.z;
    unsigned sum, cnt, mine, sp = 0u;
    for (;;) {
        sum = 0u; cnt = 0u; mine = 0u;
#pragma unroll
        for (unsigned j = 0; j < 16; ++j) { const unsigned c = xb_ld(&bar[XB_XCNT(j)]); sum += c; cnt += (c > 0u) ? 1u : 0u; mine = (j == x) ? c : mine; }
        if (sum == G) break;
        __builtin_amdgcn_s_sleep(1);
        if ((++sp & 255u) == 0u) { if (xb_ld(&bar[XB_TMO])) break; if (sp > XB_SPIN_CAP) { atomicAdd(&bar[XB_TMO], 1u); break; } }
    }
    nloc = mine > 0u ? mine : 1u; nx = cnt > 0u ? cnt : 1u;
}
__device__ __forceinline__ void xcd_barrier(const XcdBarrier& b) {
    asm volatile("s_waitcnt vmcnt(0)" ::: "memory");
    __syncthreads();
    if (threadIdx.x == 0) {
        unsigned* bar = b.bar;
        __builtin_amdgcn_s_waitcnt(0);
        unsigned nloc = b.st[0], nx = b.st[1];
        if (nloc == 0u) { xcd_barrier_complete(bar, b.x, nloc, nx); b.st[0] = nloc; b.st[1] = nx; }
        const unsigned old = xb_add(&bar[XB_XSUB(b.x)], 1u);
        const unsigned gen = old / nloc;
        if (old + 1u == (gen + 1u) * nloc) {
            __builtin_amdgcn_fence(__ATOMIC_RELEASE, "agent");
            asm volatile("s_waitcnt vmcnt(0)" ::: "memory");
            const unsigned og = xb_add(&bar[XB_TOP], 1u);
            const unsigned tg = og / nx;
            if (og + 1u == (tg + 1u) * nx) xb_add(&bar[XB_TOPGEN], 1u);
            else XB_SPIN(xb_ld(&bar[XB_TOPGEN]) == tg, bar);
            __builtin_amdgcn_fence(__ATOMIC_ACQUIRE, "agent");
            xb_add(&bar[XB_XGEN(b.x)], 1u);
            asm volatile("s_waitcnt vmcnt(0)" ::: "memory");
        } else {
            XB_SPIN(xb_ld(&bar[XB_XGEN(b.x)]) == gen, bar);
            __builtin_amdgcn_fence(__ATOMIC_ACQUIRE, "agent");
            asm volatile("s_waitcnt vmcnt(0)" ::: "memory");
        }
    }
    __syncthreads();
}
__global__ void __launch_bounds__(512) fwd_kernel(Params p_unused) {
    extern __shared__ __attribute__((aligned(16))) unsigned char lds_raw[];
    LAS unsigned char* lds = (LAS unsigned char*)lds_raw;
    cg::grid_group grid = cg::this_grid();
    const int G = gridDim.x, blk = blockIdx.x;
    const int ngw = G * 8, ngt = G * 512;
    {
        volatile LAS unsigned* xst = (volatile LAS unsigned*)(lds + 131072 + 64);
        if (threadIdx.x == 0) { xst[0] = 0u; xst[1] = 0u; }
        __syncthreads();
        (void)xcd_barrier_post((unsigned*)(get_params()->ws + WS_CTL) + CW_BAR, xst);
        grid.sync();
    }
#define GRID_SYNC() do { asm volatile("s_waitcnt vmcnt(0) lgkmcnt(0)" ::: "memory"); { XcdBarrier xb_; xb_.bar = (unsigned*)(get_params()->ws + WS_CTL) + CW_BAR; xb_.x = xb_xcc_id(); xb_.st = (volatile LAS unsigned*)(lds + 131072 + 64); xcd_barrier(xb_); } asm volatile("" ::: "memory"); } while (0)
#define FRESH_IDS() int tid = threadIdx.x; asm volatile("" : "+v"(tid)); const int lane = tid & 63, wave = __builtin_amdgcn_readfirstlane(tid >> 6), gw = blk * 8 + wave, gtid = blk * 512 + tid; (void)lane; (void)gw; (void)gtid

    { unsigned* ctl0 = (unsigned*)(get_params()->ws + WS_CTL);
      if (blk == 0 && threadIdx.x < 4) __hip_atomic_store(ctl0 + 64 * threadIdx.x, 0u, __ATOMIC_RELAXED, __HIP_MEMORY_SCOPE_AGENT); }
#pragma unroll 1
    for (int layer = 0; layer < 2; ++layer) {
        { FRESH_IDS(); ParamsCP pp = get_params(); convert_weights(pp, layer, lds, gw, ngw, wave, lane); }
        if (layer == 0) { FRESH_IDS(); ParamsCP pp = get_params(); setup_phase(pp, gtid, ngt, gw, lane); }
        { FRESH_IDS(); ParamsCP pp = get_params(); norm_phase(pp, pp->in[2] + layer * D, layer == 0, gw, ngw, lane); }
        GRID_SYNC();
        { FRESH_IDS(); ParamsCP pp = get_params(); unsigned char* ws = pp->ws;
          SchedIn S{(const char*)(ws + WS_U), (const char*)(ws + WS_WT + WT_IN), G, blk}; EpiIn E{(bf16_t*)(ws + WS_BIG + BIG_PROJ), (bf16_t*)(ws + WS_BIG + BIG_VT), (bf16_t*)(ws + WS_GATEM)}; pg8::gemm_phase(lds, S, E, tid); }
        GRID_SYNC();
        { FRESH_IDS(); ParamsCP pp = get_params(); prep_phase(pp, layer, gw, ngw, lane); }
        GRID_SYNC();
        { FRESH_IDS(); ParamsCP pp = get_params(); mixer_phase(pp, layer, lds, tid); }
        GRID_SYNC();
        { FRESH_IDS(); ParamsCP pp = get_params(); diff_post_phase(pp, layer, gw, ngw, lane); ret_post_phase(pp, layer, gw, ngw, lane); }
        GRID_SYNC();
#pragma unroll 1
        for (int br = 0; br < 3; ++br) {
            { FRESH_IDS(); ParamsCP pp = get_params(); unsigned char* ws = pp->ws;
              SchedPlain S{(const char*)(ws + WS_U), (const char*)(ws + WS_WT + WT_IN + (size_t)(9216 + br * 2048) * 4096), 4096u, 4096u, 32, 128, 8, 1, G, blk};
              EpiGate E{(bf16_t*)(ws + WS_BIG + BIG_GATE)}; pg8::gemm_phase(lds, S, E, tid); }
            GRID_SYNC();
            { FRESH_IDS(); ParamsCP pp = get_params(); unsigned char* ws = pp->ws;
              const size_t yoff = ((size_t)br * PBUF + (br == 0 ? 1024 : 0)) * 2;
              SchedPlain S{(const char*)(ws + WS_BIG + BIG_PROJ + yoff), (const char*)(ws + WS_WT + WT_BR + (size_t)br * 2048 * 4096), 4096u, 4096u, 16, 129, 8, 0, G, blk};
              EpiYM E{(const bf16_t*)(ws + WS_BIG + BIG_GATE), (bf16_t*)(ws + WS_BIG + BIG_MERGED), br == 0 ? 1 : 0, (const bf16_t*)(ws + WS_GATEM) + (size_t)br * 256 * D}; pg8::gemm_phase(lds, S, E, tid); }
            GRID_SYNC();
        }
        { FRESH_IDS(); ParamsCP pp = get_params(); unsigned char* ws = pp->ws; float* hmeta = (float*)(ws + WS_HMETA);
          SchedPlain S{(const char*)(ws + WS_BIG + BIG_MERGED), (const char*)(ws + WS_WT + WT_OUT), 4096u, 4096u, 32, 129, 8, 0, G, blk};
          EpiResid E{layer == 0 ? pp->in[0] : (const float*)pp->out, hmeta, pp->out, hmeta}; pg8::gemm_phase(lds, S, E, tid); }
        GRID_SYNC();
        { FRESH_IDS(); ParamsCP pp = get_params(); norm_phase(pp, pp->in[18] + layer * D, false, gw, ngw, lane); }
        GRID_SYNC();
        { FRESH_IDS(); ParamsCP pp = get_params(); unsigned char* ws = pp->ws;
          SchedPlain S{(const char*)(ws + WS_U), (const char*)(ws + WS_WT + WT_UP), 4096u, 4096u, 32, 129, 43, 0, G, blk};
          EpiUp E{(bf16_t*)(ws + WS_BIG + BIG_G), (bf16_t*)(ws + WS_BIG + BIG_V)}; pg8::gemm_phase(lds, S, E, tid); }
        GRID_SYNC();
        { FRESH_IDS(); ParamsCP pp = get_params(); act_phase(pp, layer, gtid, ngt); }
        GRID_SYNC();
        { FRESH_IDS(); ParamsCP pp = get_params(); unsigned char* ws = pp->ws; float* hmeta = (float*)(ws + WS_HMETA);
          const int skip = layer == 1 ? 1 : 0;
          SchedPlain S{(const char*)(ws + WS_BIG + BIG_V), (const char*)(ws + WS_WT + WT_DOWN), (unsigned)(DFF * 2), (unsigned)(DFF * 2), DFF / 64, 129 - skip, 8, skip, G, blk};
          EpiResid E{(const float*)pp->out, hmeta, pp->out, hmeta}; pg8::gemm_phase(lds, S, E, tid); }
        if (layer == 0) GRID_SYNC();
    }
}

constexpr int LDS_BYTES = 131072 + 4096;
extern "C" void kernel_launch(void* const* d_in, const int* in_sizes, int n_in, void* d_out, int out_size, void* d_ws, size_t ws_size, hipStream_t stream) {
    static int grid = 0;
    if (grid == 0) {
        if (n_in != 23 || ws_size < WS_END) { fprintf(stderr, "kernel_launch: need 23 inputs and >= %zu bytes of workspace (got %d, %zu)\n", (size_t)WS_END, n_in, ws_size); grid = -1; return; }
        int dev = 0, cus = 0, per_cu = 0;
        hipGetDevice(&dev);
        hipDeviceGetAttribute(&cus, hipDeviceAttributeMultiprocessorCount, dev);
        if (hipFuncSetAttribute((const void*)fwd_kernel, hipFuncAttributeMaxDynamicSharedMemorySize, LDS_BYTES) != hipSuccess) { fprintf(stderr, "kernel_launch: hipFuncSetAttribute failed\n"); grid = -1; return; }
        if (hipOccupancyMaxActiveBlocksPerMultiprocessor(&per_cu, (const void*)fwd_kernel, 512, LDS_BYTES) != hipSuccess || per_cu < 1) { fprintf(stderr, "kernel_launch: occupancy query failed (%d)\n", per_cu); per_cu = 1; }
        (void)hipGetLastError();
        grid = cus * per_cu; if (grid > 256) grid = 256;
    }
    if (grid < 0) return;
    hipMemsetAsync((char*)d_ws + WS_CTL, 0, CTL_BYTES, stream);
    Params p{};
    for (int i = 0; i < 23; ++i) p.in[i] = (const float*)d_in[i];
    p.out = (float*)d_out; p.ws = (unsigned char*)d_ws;
    void* args[] = {&p};
    hipError_t e = hipLaunchCooperativeKernel((const void*)fwd_kernel, dim3(grid), dim3(512), args, LDS_BYTES, stream);
    if (e != hipSuccess) fprintf(stderr, "cooperative launch failed: %s (grid %d)\n", hipGetErrorString(e), grid);
}
```

```cpp
#include <hip/hip_runtime.h>
#include <hip/hip_cooperative_groups.h>
#include <cstdio>
#include <cstdint>
namespace cg = cooperative_groups;

#define LAS __attribute__((address_space(3)))
typedef unsigned short bf16_t;
typedef short bf16x8 __attribute__((ext_vector_type(8)));
typedef short bf16x4 __attribute__((ext_vector_type(4)));
typedef float f32x4 __attribute__((ext_vector_type(4)));
typedef unsigned u32x4 __attribute__((ext_vector_type(4)));
typedef unsigned u32x2 __attribute__((ext_vector_type(2)));

constexpr int D = 2048, NBATCH = 16, SEQ = 2048, NMETA = 16, LTOK = 2064;
constexpr int M = 33024;
constexpr int RB = 256;
constexpr int NPROJ = 6144;
constexpr int PP = 2048;
constexpr size_t PBUF = (size_t)M * PP;
constexpr int NVT = 3072;
constexpr int NIN = 15360, DFF = 5504;
constexpr int C_RQ = 0, C_RK = 512, C_RG = 1024, C_DQ = 2048, C_DK = 3072, C_NQ = 4096, C_NK = 5120;
constexpr int V_RET = 0, V_DIFF = 1024, V_NA = 2048;
constexpr float EPS = 1e-6f;
constexpr float LOG2E = 1.4426950408889634f;

constexpr size_t WS_CTL = 0;
constexpr size_t CTL_BYTES = 32768;
constexpr size_t WS_MISC = 32768;
constexpr size_t WS_ROPE64 = 65536;
constexpr size_t WS_ROPE128 = WS_ROPE64 + (size_t)LTOK * 32 * 8;
constexpr size_t WS_HMETA = 2u << 20;
constexpr size_t WS_GATEM = 4u << 20;
constexpr size_t WS_WT = 8u << 20;
constexpr size_t WT_IN = 0;
constexpr size_t WT_BR = WT_IN + (size_t)NIN * D * 2;
constexpr size_t WT_OUT = WT_BR + (size_t)3 * D * 2048 * 2;
constexpr size_t WT_UP = WT_OUT + (size_t)D * D * 2;
constexpr size_t WT_DOWN = WT_UP + (size_t)2 * DFF * D * 2;
constexpr size_t WT_BYTES = WT_DOWN + (size_t)D * DFF * 2;
constexpr size_t WS_U = WS_WT + WT_BYTES;
constexpr size_t WS_BIG = WS_U + (size_t)M * D * 2;
constexpr size_t BIG_PROJ = 0;
constexpr size_t BIG_VT = (size_t)M * NPROJ * 2;
constexpr size_t BIG_MERGED = BIG_VT;
constexpr size_t BIG_GATE = BIG_MERGED + (size_t)M * D * 2;
constexpr size_t BIG_G = 0;
constexpr size_t BIG_V = (size_t)M * DFF * 2;
constexpr size_t BIG_BYTES = (size_t)2 * M * DFF * 2;
constexpr size_t WS_END = WS_BIG + BIG_BYTES;
static_assert(BIG_GATE + (size_t)M * D * 2 <= BIG_BYTES, "merged + gate buffers fit behind PROJ");
static_assert(BIG_VT + (size_t)NVT * M * 2 <= BIG_BYTES, "mixer buffers fit");
static_assert(WS_ROPE128 + (size_t)LTOK * 64 * 8 <= WS_HMETA, "rope tables");

struct Params {
    const float* in[23];
    float* out;
    unsigned char* ws;
};
typedef const Params __attribute__((address_space(4)))* ParamsCP;
__device__ __forceinline__ ParamsCP get_params() { ParamsCP q = (ParamsCP)__builtin_amdgcn_kernarg_segment_ptr(); asm volatile("" : "+s"(q)); return q; }

__device__ __forceinline__ float bf2f(unsigned short b) { return __uint_as_float(((unsigned)b) << 16); }
typedef __bf16 bf16x2_t __attribute__((ext_vector_type(2)));
typedef float f32x2_t __attribute__((ext_vector_type(2)));
__device__ __forceinline__ unsigned pk2(float lo, float hi) { f32x2_t v = {lo, hi}; bf16x2_t b = __builtin_convertvector(v, bf16x2_t); return __builtin_bit_cast(unsigned, b); }
__device__ __forceinline__ unsigned f2bf(float f) { return pk2(f, 0.f) & 0xffffu; }
__device__ __forceinline__ float lo_f(unsigned w) { return __uint_as_float(w << 16); }
__device__ __forceinline__ float hi_f(unsigned w) { return __uint_as_float(w & 0xffff0000u); }
__device__ __forceinline__ unsigned cvt_pk_bf16(float lo, float hi) { return pk2(lo, hi); }
__device__ __forceinline__ float wave_sum(float v) {
#pragma unroll
    for (int o = 1; o < 64; o <<= 1) v += __shfl_xor(v, o);
    return v;
}
__device__ __forceinline__ float wave_max(float v) {
#pragma unroll
    for (int o = 1; o < 64; o <<= 1) v = fmaxf(v, __shfl_xor(v, o));
    return v;
}
__device__ __forceinline__ float fast_exp2(float x) { return __builtin_amdgcn_exp2f(x); }
__device__ __forceinline__ float fast_rcp(float x) { return __builtin_amdgcn_rcpf(x); }
__device__ __forceinline__ float uniform_f(float x) { return __uint_as_float((unsigned)__builtin_amdgcn_readfirstlane((int)__float_as_uint(x))); }
__device__ __forceinline__ f32x4 mfma16(bf16x8 a, bf16x8 b, f32x4 c) { return __builtin_amdgcn_mfma_f32_16x16x32_bf16(a, b, c, 0, 0, 0); }
template <class T> __device__ __forceinline__ T* uniform_ptr(T* p) {
    const unsigned long long v = (unsigned long long)p;
    const unsigned lo = (unsigned)__builtin_amdgcn_readfirstlane((int)(unsigned)v), hi = (unsigned)__builtin_amdgcn_readfirstlane((int)(unsigned)(v >> 32));
    return (T*)(((unsigned long long)hi << 32) | lo);
}
__device__ __forceinline__ int tile_row(int b, int j) { return j == 0 ? b * 16 : (RB - 16) + b * SEQ + 16 * j; }

namespace pg8 {
constexpr int BM = 256, BK = 64, HALF = 128, HTB = HALF * BK * 2, STAGE_BYTES = 8 * HTB, NXCD = 8, WGM = 8;
__device__ __forceinline__ int lds_byte(int r, int c) { const int st = (r >> 4) * 2 + (c >> 5), rr = r & 15, cc = c & 31, ob = rr * 64 + cc * 2; return st * 1024 + (ob ^ (((ob >> 9) & 1) << 5)); }
__device__ __forceinline__ void stage_rc(int b, int& R, int& C) { const int st = b / 1024, sb = b % 1024, swz = sb ^ (((sb >> 9) & 1) << 5); R = (st >> 1) * 16 + swz / 64; C = (st & 1) * 32 + (swz % 64) / 2; }
__device__ __forceinline__ int perm32(int rho) { const int n = rho >> 4, i = rho & 15; return 8 * (i >> 2) + 4 * n + (i & 3); }

struct GUnit { const char* A; const char* B; unsigned lda, ldb; int nt, kind, pm, pn; };

__device__ __forceinline__ void tile_map(int L, int nM, int nN, int& pm, int& pn) {
    const int nwg = nM * nN; int wgid = L;
    { const int q = nwg / NXCD, r = nwg % NXCD, xcd = wgid % NXCD, off = wgid / NXCD; wgid = (xcd < r ? xcd * (q + 1) : r * (q + 1) + (xcd - r) * q) + off; }
    const int nig = WGM * nN, gid = wgid / nig, fm = gid * WGM, gsz = (nM - fm) < WGM ? (nM - fm) : WGM;
    pm = fm + ((wgid % nig) % gsz); pn = (wgid % nig) / gsz;
}

template <class Epi, class Sched>
__device__ __forceinline__ void gemm_phase(LAS unsigned char* lds, const Sched& S, const Epi& E, const int tid) {
    const int wid = __builtin_amdgcn_readfirstlane(tid >> 6), lane = tid & 63, wr = wid >> 2, wc = wid & 3, fr = lane & 15, fq = lane >> 4;
    int sR[2], sC[2], sRbi[2];
#pragma unroll
    for (int i = 0; i < 2; ++i) { stage_rc(tid * 16 + i * 8192, sR[i], sC[i]); sRbi[i] = (sR[i] & ~31) + perm32(sR[i] & 31); }
    const unsigned ldsw = (unsigned)wid * 1024u;
    const int aoff = lds_byte(wr * 64 + fr, fq * 8), boff = lds_byte(wc * 32 + fr, fq * 8);
#define PG8_SA(b, h) (((b) * 2 + (h)) * HTB)
#define PG8_SB(b, h) ((4 + (b) * 2 + (h)) * HTB)
#define PG8_STAGE(bufoff, gbase, rows) do { _Pragma("unroll") for (int _i = 0; _i < 2; ++_i) \
        __builtin_amdgcn_global_load_lds((const unsigned*)((const char*)(gbase) + (rows)[_i]), (LAS unsigned*)(lds + (bufoff) + ldsw + _i * 8192), 16, 0, 0); } while (0)
#define PG8_LDA(dst, b, h) do { _Pragma("unroll") for (int m = 0; m < 4; ++m) _Pragma("unroll") for (int k = 0; k < 2; ++k) dst[m][k] = *(const LAS bf16x8*)(lds + PG8_SA(b, h) + aoff + m * 2048 + k * 1024); } while (0)
#define PG8_LDB(dst, b, h) do { _Pragma("unroll") for (int n = 0; n < 2; ++n) _Pragma("unroll") for (int k = 0; k < 2; ++k) dst[n][k] = *(const LAS bf16x8*)(lds + PG8_SB(b, h) + boff + n * 2048 + k * 1024); } while (0)
#define PG8_MMA(ai, bj, At, Bt) do { __builtin_amdgcn_s_setprio(1); _Pragma("unroll") for (int m = 0; m < 4; ++m) _Pragma("unroll") for (int n = 0; n < 2; ++n) _Pragma("unroll") for (int k = 0; k < 2; ++k) \
        acc[ai][bj][m][n] = __builtin_amdgcn_mfma_f32_16x16x32_bf16(Bt[n][k], At[m][k], acc[ai][bj][m][n], 0, 0, 0); __builtin_amdgcn_s_setprio(0); } while (0)
#define PG8_WAIT_V(n) asm volatile("s_waitcnt vmcnt(" #n ")" ::: "memory")
#define PG8_WAIT_L(n) asm volatile("s_waitcnt lgkmcnt(" #n ")" ::: "memory")
#define PG8_BAR __builtin_amdgcn_s_barrier()
#define PG8_SCHED __builtin_amdgcn_sched_barrier(0)
    GUnit cur, nxt; int ui = 0;
    if (!S.next(0, cur)) return;
    f32x4 acc[2][2][4][2];
#pragma unroll
    for (int a = 0; a < 2; ++a)
#pragma unroll
        for (int b = 0; b < 2; ++b)
#pragma unroll
            for (int m = 0; m < 4; ++m)
#pragma unroll
                for (int n = 0; n < 2; ++n) acc[a][b][m][n] = (f32x4){0.f, 0.f, 0.f, 0.f};
    bf16x8 At[4][2], B0[2][2], B1[2][2];
    const char* cA = cur.A; const char* cB = cur.B;
    constexpr unsigned kstep = (unsigned)(BK * 2);
    const unsigned lda = cur.lda, ldb = cur.ldb, hA = HALF * lda, hB = HALF * ldb;
    unsigned vA[2], vB[2];
#pragma unroll
    for (int i = 0; i < 2; ++i) { vA[i] = (unsigned)sR[i] * lda + (unsigned)sC[i] * 2u; vB[i] = (unsigned)sRbi[i] * ldb + (unsigned)sC[i] * 2u; }
    PG8_STAGE(PG8_SB(0, 0), cB, vB); PG8_STAGE(PG8_SB(0, 1), cB + hB, vB); PG8_STAGE(PG8_SA(0, 0), cA, vA); PG8_STAGE(PG8_SA(0, 1), cA + hA, vA);
    if (wr == 1) PG8_BAR;
    PG8_WAIT_V(2); PG8_BAR;
    PG8_STAGE(PG8_SB(1, 0), cB + kstep, vB); PG8_STAGE(PG8_SA(1, 0), cA + kstep, vA); PG8_STAGE(PG8_SB(1, 1), cB + hB + kstep, vB);
    PG8_WAIT_V(6); PG8_BAR;
    for (;;) {
        const bool has_next = S.next(ui + 1, nxt);
        const char* nA = has_next ? nxt.A : cA; const char* nB = has_next ? nxt.B : cB;
        const int nt = cur.nt;
        for (int t = 0; t < nt; t += 2) {
            const bool last = (t == nt - 2);
            const char* a1 = cA + (size_t)(t + 1) * kstep;
            const char* a2 = last ? nA : cA + (size_t)(t + 2) * kstep; const char* b2 = last ? nB : cB + (size_t)(t + 2) * kstep;
            const char* a3 = a2 + kstep; const char* b3 = b2 + kstep;
            PG8_LDB(B0, 0, 0); PG8_LDB(B1, 0, 1); PG8_SCHED; PG8_LDA(At, 0, 0); PG8_STAGE(PG8_SA(1, 1), a1 + hA, vA);
            PG8_WAIT_V(8); PG8_WAIT_L(0); PG8_BAR; PG8_MMA(0, 0, At, B0); PG8_MMA(0, 1, At, B1); PG8_BAR; PG8_SCHED;
            PG8_LDA(At, 0, 1); PG8_STAGE(PG8_SB(0, 0), b2, vB); PG8_STAGE(PG8_SB(0, 1), b2 + hB, vB); PG8_STAGE(PG8_SA(0, 0), a2, vA);
            PG8_WAIT_V(8); PG8_WAIT_L(0); PG8_BAR; PG8_MMA(1, 0, At, B0); PG8_MMA(1, 1, At, B1); PG8_BAR; PG8_SCHED;
            PG8_LDB(B0, 1, 0); PG8_LDB(B1, 1, 1); PG8_SCHED; PG8_LDA(At, 1, 0); PG8_STAGE(PG8_SA(0, 1), a2 + hA, vA);
            PG8_WAIT_V(8); PG8_WAIT_L(0); PG8_BAR; PG8_MMA(0, 0, At, B0); PG8_MMA(0, 1, At, B1); PG8_BAR; PG8_SCHED;
            PG8_LDA(At, 1, 1); PG8_STAGE(PG8_SB(1, 0), b3, vB); PG8_STAGE(PG8_SB(1, 1), b3 + hB, vB); PG8_STAGE(PG8_SA(1, 0), a3, vA);
            PG8_WAIT_V(8); PG8_WAIT_L(0); PG8_BAR; PG8_MMA(1, 0, At, B0); PG8_MMA(1, 1, At, B1); PG8_BAR; PG8_SCHED;
        }
        if (wr == 0) PG8_BAR;
        E(acc, cur);
        if (!has_next) break;
#pragma unroll
        for (int a = 0; a < 2; ++a)
#pragma unroll
            for (int b = 0; b < 2; ++b)
#pragma unroll
                for (int m = 0; m < 4; ++m)
#pragma unroll
                    for (int n = 0; n < 2; ++n) acc[a][b][m][n] = (f32x4){0.f, 0.f, 0.f, 0.f};
        cur = nxt; cA = nA; cB = nB; ++ui;
        if (wr == 1) PG8_BAR;
    }
    PG8_WAIT_V(0);
    PG8_BAR;
#undef PG8_SA
#undef PG8_SB
#undef PG8_STAGE
#undef PG8_LDA
#undef PG8_LDB
#undef PG8_MMA
#undef PG8_WAIT_V
#undef PG8_WAIT_L
#undef PG8_BAR
#undef PG8_SCHED
}
}
using pg8::GUnit;

struct SchedIn {
    const char* U; const char* WT; int G, c;
    __device__ __forceinline__ bool next(int i, GUnit& u) const {
        const int L = i * G + c; int pm, pn;
        if (L < 3096) { pg8::tile_map(L, 129, 24, pm, pn); u.A = U + (size_t)pm * 256 * 4096; u.B = WT + (size_t)pn * 256 * 4096; u.kind = 0; }
        else if (L < 3096 + 1548) { pg8::tile_map(L - 3096, 12, 129, pm, pn); u.A = WT + (size_t)(NPROJ + pm * 256) * 4096; u.B = U + (size_t)pn * 256 * 4096; u.kind = 1; }
        else if (L < 3096 + 1548 + 24) { const int idx = L - (3096 + 1548); pm = idx >> 3; pn = idx & 7;
            u.A = U; u.B = WT + (size_t)(9216 + pm * 2048 + pn * 256) * 4096; u.kind = 2; }
        else return false;
        u.pm = pm; u.pn = pn; u.lda = 4096; u.ldb = 4096; u.nt = 32; return true;
    }
};
struct SchedPlain {
    const char* A; const char* B; unsigned lda, ldb; int nt, nM, nN, pm0, G, c;
    __device__ __forceinline__ bool next(int i, GUnit& u) const {
        const int L = i * G + c; if (L >= nM * nN) return false;
        int pm, pn; pg8::tile_map(L, nM, nN, pm, pn); pm += pm0;
        u.pm = pm; u.pn = pn; u.kind = 0; u.A = A + (size_t)pm * 256 * lda; u.B = B + (size_t)pn * 256 * ldb; u.lda = lda; u.ldb = ldb; u.nt = nt; return true;
    }
};

struct LaneId { int wr, wc, fr, fq; };
__device__ __forceinline__ LaneId lane_id_fresh() { int t = threadIdx.x; asm volatile("" : "+v"(t)); LaneId r; r.wr = t >> 8; r.wc = (t >> 6) & 3; r.fr = t & 15; r.fq = (t >> 4) & 3; return r; }
__device__ __forceinline__ float sigmoid_f(float x) { return fast_rcp(1.0f + fast_exp2(-x * LOG2E)); }
struct EpiIn {
    bf16_t* PROJ; bf16_t* VT; bf16_t* GATEM;
    __device__ __forceinline__ void operator()(const f32x4 (&acc)[2][2][4][2], const GUnit& u) const {
        const LaneId L_ = lane_id_fresh(); const int wr = L_.wr, wc = L_.wc, fr = L_.fr, fq = L_.fq;
        char* base; unsigned ldb2;
        if (u.kind == 0) { base = (char*)(PROJ + (size_t)(u.pn >> 3) * PBUF + (size_t)u.pm * 256 * PP + (size_t)(u.pn & 7) * 256); ldb2 = PP * 2; }
        else if (u.kind == 1) { base = (char*)(VT + (size_t)u.pm * 256 * M + (size_t)u.pn * 256); ldb2 = M * 2; }
        else { base = (char*)(GATEM + (size_t)u.pm * 256 * D + (size_t)u.pn * 256); ldb2 = D * 2; }
        base = uniform_ptr(base);
        const unsigned lo = (unsigned)(wr * 64 + fr) * ldb2 + (unsigned)(wc * 32 + 8 * fq) * 2u;
        const bool sg = u.kind == 2;
#pragma unroll
        for (int ai = 0; ai < 2; ++ai)
#pragma unroll
            for (int m = 0; m < 4; ++m) { const unsigned ro = lo + (unsigned)(ai * 128 + m * 16) * ldb2;
#pragma unroll
                for (int bj = 0; bj < 2; ++bj) { f32x4 v0 = acc[ai][bj][m][0], v1 = acc[ai][bj][m][1];
                    if (sg) {
#pragma unroll
                        for (int j = 0; j < 4; ++j) { v0[j] = sigmoid_f(v0[j]); v1[j] = sigmoid_f(v1[j]); } }
                    u32x4 w; w.x = cvt_pk_bf16(v0[0], v0[1]); w.y = cvt_pk_bf16(v0[2], v0[3]); w.z = cvt_pk_bf16(v1[0], v1[1]); w.w = cvt_pk_bf16(v1[2], v1[3]);
                    *(u32x4*)(base + (ro + bj * 256u)) = w; } }
    }
};
struct EpiGate {
    bf16_t* GATE;
    __device__ __forceinline__ void operator()(const f32x4 (&acc)[2][2][4][2], const GUnit& u) const {
        const LaneId L_ = lane_id_fresh(); const int wr = L_.wr, wc = L_.wc, fr = L_.fr, fq = L_.fq;
        char* gb = uniform_ptr((char*)(GATE + (size_t)u.pm * 256 * D + (size_t)u.pn * 256));
        const unsigned lo = (unsigned)(wr * 64 + fr) * (D * 2u) + (unsigned)(wc * 32 + 8 * fq) * 2u;
#pragma unroll
        for (int ai = 0; ai < 2; ++ai)
#pragma unroll
            for (int m = 0; m < 4; ++m)
#pragma unroll
                for (int bj = 0; bj < 2; ++bj) { const f32x4 v0 = acc[ai][bj][m][0], v1 = acc[ai][bj][m][1];
                    u32x4 w; w.x = cvt_pk_bf16(sigmoid_f(v0[0]), sigmoid_f(v0[1])); w.y = cvt_pk_bf16(sigmoid_f(v0[2]), sigmoid_f(v0[3]));
                    w.z = cvt_pk_bf16(sigmoid_f(v1[0]), sigmoid_f(v1[1])); w.w = cvt_pk_bf16(sigmoid_f(v1[2]), sigmoid_f(v1[3]));
                    *(u32x4*)(gb + (lo + (unsigned)(ai * 128 + m * 16) * (D * 2u) + bj * 256u)) = w; }
    }
};
struct EpiYM {
    const bf16_t* GATE; bf16_t* MERGED; int first; const bf16_t* GATEM;
    __device__ __forceinline__ void operator()(const f32x4 (&acc)[2][2][4][2], const GUnit& u) const {
        const LaneId L_ = lane_id_fresh(); const int wr = L_.wr, wc = L_.wc, fr = L_.fr, fq = L_.fq;
        const size_t tb = (size_t)u.pm * 256 * D + (size_t)u.pn * 256;
        const char* gb = uniform_ptr((const char*)(u.pm == 0 ? GATEM + (size_t)u.pn * 256 : GATE + tb)); char* mgb = uniform_ptr((char*)(MERGED + tb));
        const unsigned lo = (unsigned)(wr * 64 + fr) * (D * 2u) + (unsigned)(wc * 32 + 8 * fq) * 2u;
#pragma unroll
        for (int ai = 0; ai < 2; ++ai) {
            u32x4 gq[4][2], pq[4][2];
#pragma unroll
            for (int m = 0; m < 4; ++m)
#pragma unroll
                for (int bj = 0; bj < 2; ++bj) { const unsigned o = lo + (unsigned)(ai * 128 + m * 16) * (D * 2u) + bj * 256u;
                    gq[m][bj] = *(const u32x4*)(gb + o); pq[m][bj] = first ? (u32x4){0u, 0u, 0u, 0u} : *(const u32x4*)(mgb + o); }
#pragma unroll
            for (int m = 0; m < 4; ++m)
#pragma unroll
                for (int bj = 0; bj < 2; ++bj) { const f32x4 v0 = acc[ai][bj][m][0], v1 = acc[ai][bj][m][1];
                    const unsigned o = lo + (unsigned)(ai * 128 + m * 16) * (D * 2u) + bj * 256u;
                    const u32x4 g = gq[m][bj], p = pq[m][bj];
                    float r[8];
                    r[0] = v0[0] * lo_f(g.x) + lo_f(p.x); r[1] = v0[1] * hi_f(g.x) + hi_f(p.x); r[2] = v0[2] * lo_f(g.y) + lo_f(p.y); r[3] = v0[3] * hi_f(g.y) + hi_f(p.y);
                    r[4] = v1[0] * lo_f(g.z) + lo_f(p.z); r[5] = v1[1] * hi_f(g.z) + hi_f(p.z); r[6] = v1[2] * lo_f(g.w) + lo_f(p.w); r[7] = v1[3] * hi_f(g.w) + hi_f(p.w);
                    u32x4 w; w.x = cvt_pk_bf16(r[0], r[1]); w.y = cvt_pk_bf16(r[2], r[3]); w.z = cvt_pk_bf16(r[4], r[5]); w.w = cvt_pk_bf16(r[6], r[7]);
                    *(u32x4*)(mgb + o) = w; }
            asm volatile("" ::: "memory");
        }
    }
};
struct EpiResid {
    const float* in_real; const float* in_meta; float* out_real; float* out_meta;
    __device__ __forceinline__ void operator()(const f32x4 (&acc)[2][2][4][2], const GUnit& u) const {
        const LaneId L_ = lane_id_fresh(); const int wr = L_.wr, wc = L_.wc, fr = L_.fr, fq = L_.fq;
        const char* ip; char* op;
        if (u.pm == 0) { ip = (const char*)(in_meta + u.pn * 256); op = (char*)(out_meta + u.pn * 256); }
        else { ip = (const char*)(in_real + (size_t)(u.pm - 1) * 256 * D + u.pn * 256); op = (char*)(out_real + (size_t)(u.pm - 1) * 256 * D + u.pn * 256); }
        ip = uniform_ptr(ip); op = uniform_ptr(op);
        const unsigned lo = (unsigned)(wr * 64 + fr) * (D * 4u) + (unsigned)(wc * 32 + 8 * fq) * 4u;
#pragma unroll
        for (int ai = 0; ai < 2; ++ai) {
            f32x4 ra[4][2], rb[4][2];
#pragma unroll
            for (int m = 0; m < 4; ++m)
#pragma unroll
                for (int bj = 0; bj < 2; ++bj) { const unsigned o = lo + (unsigned)(ai * 128 + m * 16) * (D * 4u) + bj * 512u; ra[m][bj] = *(const f32x4*)(ip + o); rb[m][bj] = *(const f32x4*)(ip + (o + 16u)); }
#pragma unroll
            for (int m = 0; m < 4; ++m)
#pragma unroll
                for (int bj = 0; bj < 2; ++bj) { const unsigned o = lo + (unsigned)(ai * 128 + m * 16) * (D * 4u) + bj * 512u;
                    *(f32x4*)(op + o) = ra[m][bj] + acc[ai][bj][m][0]; *(f32x4*)(op + (o + 16u)) = rb[m][bj] + acc[ai][bj][m][1]; }
            asm volatile("" ::: "memory");
        }
    }
};
struct EpiUp {
    bf16_t* Gb; bf16_t* Vb;
    __device__ __forceinline__ void operator()(const f32x4 (&acc)[2][2][4][2], const GUnit& u) const {
        const LaneId L_ = lane_id_fresh(); const int wr = L_.wr, wc = L_.wc, fr = L_.fr, fq = L_.fq;
        const size_t tb = (size_t)u.pm * 256 * DFF + (size_t)u.pn * 128;
        char* gb = uniform_ptr((char*)(Gb + tb)); char* vb = uniform_ptr((char*)(Vb + tb));
        const unsigned lo = (unsigned)(wr * 64 + fr) * (DFF * 2u) + (unsigned)(wc * 32 + 8 * fq) * 2u;
#pragma unroll
        for (int ai = 0; ai < 2; ++ai)
#pragma unroll
            for (int m = 0; m < 4; ++m)
#pragma unroll
                for (int bj = 0; bj < 2; ++bj) { const f32x4 v0 = acc[ai][bj][m][0], v1 = acc[ai][bj][m][1];
                    u32x4 w; w.x = cvt_pk_bf16(v0[0], v0[1]); w.y = cvt_pk_bf16(v0[2], v0[3]); w.z = cvt_pk_bf16(v1[0], v1[1]); w.w = cvt_pk_bf16(v1[2], v1[3]);
                    *(u32x4*)((bj == 0 ? gb : vb) + (lo + (unsigned)(ai * 128 + m * 16) * (DFF * 2u))) = w; }
    }
};

__device__ __forceinline__ void transpose_item(const float* W, int K, int N, bf16_t* WT, int pitch, int kb, int n0, int drow0, LAS float* scr, int lane) {
    const int k0 = 64 * kb;
#pragma unroll 8
    for (int i = 0; i < 32; ++i) { const int kk = 2 * i + (lane >> 5); scr[kk * 33 + (lane & 31)] = W[(size_t)(k0 + kk) * N + n0 + (lane & 31)]; }
    asm volatile("s_waitcnt lgkmcnt(0)" ::: "memory");
    const int c = lane & 7;
#pragma unroll
    for (int j = 0; j < 4; ++j) { const int n = (lane >> 3) + 8 * j; const LAS float* s = scr + (8 * c) * 33 + n;
        u32x4 o; o.x = pk2(s[0 * 33], s[1 * 33]); o.y = pk2(s[2 * 33], s[3 * 33]); o.z = pk2(s[4 * 33], s[5 * 33]); o.w = pk2(s[6 * 33], s[7 * 33]);
        *(u32x4*)(WT + (size_t)(drow0 + n) * pitch + k0 + 8 * c) = o; }
    asm volatile("s_waitcnt lgkmcnt(0)" ::: "memory");
}
__device__ __forceinline__ int remap_in(int n) {
    if (n < 1024) return n;
    if (n < 2048) return NPROJ + V_RET + (n - 1024);
    if (n < 3072) return C_RG + (n - 2048);
    if (n < 5120) return C_DQ + (n - 3072);
    if (n < 6144) return NPROJ + V_DIFF + (n - 5120);
    if (n < 8192) return C_NQ + (n - 6144);
    if (n < 9216) return NPROJ + V_NA + (n - 8192);
    return n;
}
__device__ __forceinline__ int remap_up(int n) { return n < DFF ? (n / 128) * 256 + (n % 128) : ((n - DFF) / 128) * 256 + 128 + ((n - DFF) % 128); }

constexpr int CW_I_DN = (DFF / 64) * (D / 32), CW_NITEMS = (D / 64) * (NIN / 32) + 3 * (1024 / 64) * (D / 32) + (D / 64) * (D / 32) + (D / 64) * (2 * DFF / 32) + CW_I_DN;
__device__ __forceinline__ void convert_weights(ParamsCP pp, int layer, LAS unsigned char* lds, int gw, int ngw, int wave, int lane, int it0 = 0, int it1 = CW_NITEMS) {
    LAS float* scr = (LAS float*)(lds + wave * 16384);
    unsigned char* wt = pp->ws + WS_WT;
    constexpr int I_IN = (D / 64) * (NIN / 32), I_BR = (1024 / 64) * (D / 32), I_OUT = (D / 64) * (D / 32), I_UP = (D / 64) * (2 * DFF / 32), I_DN = (DFF / 64) * (D / 32);
    constexpr int NITEMS = I_IN + 3 * I_BR + I_OUT + I_UP + I_DN;
    static_assert(NITEMS == CW_NITEMS && I_DN == CW_I_DN, "item counts");
    for (int it = it0 + gw; it < it1; it += ngw) {
        int r = it;
        if (r < I_IN) { const int nblk = NIN / 32, kb = r / nblk, n0 = 32 * (r % nblk);
            transpose_item(pp->in[3] + (size_t)layer * D * NIN, D, NIN, (bf16_t*)(wt + WT_IN), D, kb, n0, remap_in(n0), scr, lane); continue; }
        r -= I_IN;
        if (r < 3 * I_BR) { const int br = r / I_BR; r -= br * I_BR; const int nblk = D / 32, kb = r / nblk, n0 = 32 * (r % nblk);
            transpose_item(pp->in[14 + br] + (size_t)layer * 1024 * D, 1024, D, (bf16_t*)(wt + WT_BR) + (size_t)br * D * 2048, 2048, kb, n0, n0, scr, lane); continue; }
        r -= 3 * I_BR;
        if (r < I_OUT) { const int nblk = D / 32, kb = r / nblk, n0 = 32 * (r % nblk);
            transpose_item(pp->in[17] + (size_t)layer * D * D, D, D, (bf16_t*)(wt + WT_OUT), D, kb, n0, n0, scr, lane); continue; }
        r -= I_OUT;
        if (r < I_UP) { const int nblk = 2 * DFF / 32, kb = r / nblk, n0 = 32 * (r % nblk);
            transpose_item(pp->in[19] + (size_t)layer * D * 2 * DFF, D, 2 * DFF, (bf16_t*)(wt + WT_UP), D, kb, n0, remap_up(n0), scr, lane); continue; }
        r -= I_UP;
        { const int nblk = D / 32, kb = r / nblk, n0 = 32 * (r % nblk);
            transpose_item(pp->in[22] + (size_t)layer * DFF * D, DFF, D, (bf16_t*)(wt + WT_DOWN), DFF, kb, n0, n0, scr, lane); }
    }
}

__device__ __forceinline__ void norm_row(const float* hrow, const float* g, bf16_t* urow, int lane) {
    const f32x4* xr = (const f32x4*)hrow + lane; const f32x4* gr = (const f32x4*)g + lane;
    f32x4 v[8], gg[8]; float s = 0.f;
#pragma unroll
    for (int j = 0; j < 8; ++j) { v[j] = xr[64 * j]; gg[j] = gr[64 * j]; }
#pragma unroll
    for (int j = 0; j < 8; ++j) s += (v[j].x * v[j].x + v[j].y * v[j].y) + (v[j].z * v[j].z + v[j].w * v[j].w);
    const float rstd = rsqrtf(wave_sum(s) * (1.0f / D) + EPS);
    u32x2* o8 = (u32x2*)urow + lane;
#pragma unroll
    for (int j = 0; j < 8; ++j) { u32x2 w; w.x = pk2(v[j].x * rstd * gg[j].x, v[j].y * rstd * gg[j].y); w.y = pk2(v[j].z * rstd * gg[j].z, v[j].w * rstd * gg[j].w); o8[64 * j] = w; }
}
__device__ __forceinline__ void norm_phase(ParamsCP pp, const float* gain, bool layer0_input, int gw, int ngw, int lane, int m0 = 0, int m1 = M) {
    bf16_t* U = (bf16_t*)(pp->ws + WS_U); const float* hmeta = (const float*)(pp->ws + WS_HMETA);
    for (int m = m0 + gw; m < m1; m += ngw) {
        const float* hrow;
        if (m < RB) hrow = layer0_input ? pp->in[1] + (size_t)(m & 15) * D : hmeta + (size_t)m * D;
        else hrow = (layer0_input ? pp->in[0] : (const float*)pp->out) + (size_t)(m - RB) * D;
        norm_row(hrow, gain, U + (size_t)m * D, lane);
    }
}

__device__ __forceinline__ void setup_phase(ParamsCP pp, int gtid, int ngt, int gw, int lane) {
    float2* r64 = (float2*)(pp->ws + WS_ROPE64); float2* r128 = (float2*)(pp->ws + WS_ROPE128);
    for (int i = gtid; i < LTOK * 32; i += ngt) { const int pos = i >> 5, f = i & 31; const float inv = powf(10000.0f, -(float)(2 * f) / 64.0f); float s, c; sincosf((float)pos * inv, &s, &c); r64[i] = make_float2(c, s); }
    for (int i = gtid; i < LTOK * 64; i += ngt) { const int pos = i >> 6, f = i & 63; const float inv = powf(10000.0f, -(float)(2 * f) / 128.0f); float s, c; sincosf((float)pos * inv, &s, &c); r128[i] = make_float2(c, s); }
    float* hmeta = (float*)(pp->ws + WS_HMETA);
    for (int i = gtid; i < 256 * D; i += ngt) { const int m = i / D, cidx = i % D; hmeta[i] = pp->in[1][(size_t)(m & 15) * D + cidx]; }
    if (gw < 2) {
        const int l = gw; float* misc = (float*)(pp->ws + WS_MISC) + 16 * l;
        const float* lv = pp->in[9] + (size_t)l * 512;
        float d01 = lv[lane] * lv[128 + lane] + lv[64 + lane] * lv[192 + lane];
        float d23 = lv[256 + lane] * lv[384 + lane] + lv[320 + lane] * lv[448 + lane];
        d01 = wave_sum(d01); d23 = wave_sum(d23);
        const float lam_init = (l == 0) ? 0.2f : 0.35550907f;
        const float lam = expf(d01) - expf(d23) + lam_init;
        const float* qg = pp->in[7] + l * 128; const float* kg = pp->in[8] + l * 128;
        const float gq = wave_max(fmaxf(fabsf(qg[lane]), fabsf(qg[64 + lane]))), gk = wave_max(fmaxf(fabsf(kg[lane]), fabsf(kg[64 + lane])));
        const float dbound = 11.3137085f * gq * gk * 1.02f;
        const float nqg = wave_max(fabsf(pp->in[11][l * 64 + lane])), nkg = wave_max(fabsf(pp->in[12][l * 64 + lane]));
        float rm = 0.f; const float* rpb = pp->in[13] + (size_t)l * 7440;
        for (int i = lane; i < 7440; i += 64) rm = fmaxf(rm, fabsf(rpb[i]));
        rm = wave_max(rm);
        const float nbound = 8.0f * nqg * nkg * 1.02f + rm;
        if (lane == 0) { misc[0] = lam; misc[1] = dbound; misc[2] = nbound; misc[3] = lam_init; }
    }
}

__device__ __forceinline__ void prep_phase(ParamsCP pp, int layer, int gw, int ngw, int lane) {
    bf16_t* PROJ = (bf16_t*)(pp->ws + WS_BIG + BIG_PROJ);
    const float2* r64 = (const float2*)(pp->ws + WS_ROPE64); const float2* r128 = (const float2*)(pp->ws + WS_ROPE128);
    const float* dqg = pp->in[7] + layer * 128; const float* dkg = pp->in[8] + layer * 128;
    const float* nqg = pp->in[11] + layer * 64; const float* nkg = pp->in[12] + layer * 64;
    const int g4 = lane >> 4, l16 = lane & 15, g2 = lane >> 5, l32 = lane & 31;
    const float dq0 = dqg[2 * l32], dq1 = dqg[2 * l32 + 1], dq2 = dqg[64 + 2 * l32], dq3 = dqg[64 + 2 * l32 + 1];
    const float dk0 = dkg[2 * l32], dk1 = dkg[2 * l32 + 1], dk2 = dkg[64 + 2 * l32], dk3 = dkg[64 + 2 * l32 + 1];
    const f32x4 nq4 = *(const f32x4*)(nqg + 4 * l16), nk4 = *(const f32x4*)(nkg + 4 * l16);
    for (int m = gw; m < M; m += ngw) {
        const int pos = m < RB ? (m & 15) : 16 + ((m - RB) & (SEQ - 1));
        bf16_t* row = PROJ + (size_t)m * PP; bf16_t* rowD = row + PBUF; bf16_t* rowN = row + 2 * PBUF;
        const float2 c64a = r64[pos * 32 + 2 * l16], c64b = r64[pos * 32 + 2 * l16 + 1], c128a = r128[pos * 64 + 2 * l32], c128b = r128[pos * 64 + 2 * l32 + 1];
        unsigned r1[4], r2[4], d1[8], d2[8]; u32x2 nn[8];
#pragma unroll
        for (int ps = 0; ps < 4; ++ps) { const int grp = ps * 4 + g4; r1[ps] = *(const unsigned*)(row + grp * 64 + 2 * l16); r2[ps] = *(const unsigned*)(row + grp * 64 + 32 + 2 * l16); }
#pragma unroll
        for (int ps = 0; ps < 8; ++ps) { const int grp = ps * 2 + g2; d1[ps] = *(const unsigned*)(rowD + grp * 128 + 2 * l32); d2[ps] = *(const unsigned*)(rowD + grp * 128 + 64 + 2 * l32); }
#pragma unroll
        for (int ps = 0; ps < 8; ++ps) { const int grp = ps * 4 + g4; nn[ps] = *(const u32x2*)(rowN + grp * 64 + 4 * l16); }
#pragma unroll
        for (int ps = 0; ps < 4; ++ps) { const int grp = ps * 4 + g4; const float sc = grp >= 8 ? 0.125f : 1.0f;
            const float a0 = lo_f(r1[ps]), a1 = hi_f(r1[ps]), b0 = lo_f(r2[ps]), b1 = hi_f(r2[ps]);
            *(unsigned*)(row + grp * 64 + 2 * l16) = pk2((a0 * c64a.x - b0 * c64a.y) * sc, (a1 * c64b.x - b1 * c64b.y) * sc);
            *(unsigned*)(row + grp * 64 + 32 + 2 * l16) = pk2((a0 * c64a.y + b0 * c64a.x) * sc, (a1 * c64b.y + b1 * c64b.x) * sc); }
#pragma unroll
        for (int ps = 0; ps < 8; ++ps) { const int grp = ps * 2 + g2; const bool isk = grp >= 8;
            float a0 = lo_f(d1[ps]), a1 = hi_f(d1[ps]), b0 = lo_f(d2[ps]), b1 = hi_f(d2[ps]);
            float ss = (a0 * a0 + a1 * a1) + (b0 * b0 + b1 * b1);
#pragma unroll
            for (int o = 1; o < 32; o <<= 1) ss += __shfl_xor(ss, o);
            const float rstd = rsqrtf(ss * (1.0f / 128.0f) + EPS);
            a0 *= rstd * (isk ? dk0 : dq0); a1 *= rstd * (isk ? dk1 : dq1); b0 *= rstd * (isk ? dk2 : dq2); b1 *= rstd * (isk ? dk3 : dq3);
            *(unsigned*)(rowD + grp * 128 + 2 * l32) = pk2(a0 * c128a.x - b0 * c128a.y, a1 * c128b.x - b1 * c128b.y);
            *(unsigned*)(rowD + grp * 128 + 64 + 2 * l32) = pk2(a0 * c128a.y + b0 * c128a.x, a1 * c128b.y + b1 * c128b.x); }
#pragma unroll
        for (int ps = 0; ps < 8; ++ps) { const int grp = ps * 4 + g4; const f32x4 gn = grp >= 16 ? nk4 : nq4;
            const float a0 = lo_f(nn[ps].x), a1 = hi_f(nn[ps].x), a2 = lo_f(nn[ps].y), a3 = hi_f(nn[ps].y);
            float ss = (a0 * a0 + a1 * a1) + (a2 * a2 + a3 * a3);
#pragma unroll
            for (int o = 1; o < 16; o <<= 1) ss += __shfl_xor(ss, o);
            const float rstd = rsqrtf(ss * (1.0f / 64.0f) + EPS);
            u32x2 o2; o2.x = pk2(a0 * rstd * gn.x, a1 * rstd * gn.y); o2.y = pk2(a2 * rstd * gn.z, a3 * rstd * gn.w);
            *(u32x2*)(rowN + grp * 64 + 4 * l16) = o2; }
    }
}

__device__ __forceinline__ int act_prev_row(int m) { if (m < RB) return (m & 15) > 0 ? m - 1 : -1; const int s = (m - RB) & (SEQ - 1), b = (m - RB) >> 11; return s > 0 ? m - 1 : b * 16 + 15; }
__device__ __forceinline__ int act_next_row(int m) { if (m < RB) return (m & 15) < 15 ? m + 1 : RB + (m >> 4) * SEQ; const int s = (m - RB) & (SEQ - 1); return s < SEQ - 1 ? m + 1 : -1; }
__device__ __forceinline__ void act_phase(ParamsCP pp, int layer, int gtid, int ngt) {
    const bf16_t* Gb = (const bf16_t*)(pp->ws + WS_BIG + BIG_G); bf16_t* Vb = (bf16_t*)(pp->ws + WS_BIG + BIG_V);
    const float* cw = pp->in[20] + (size_t)layer * 3 * DFF; const float* cb = pp->in[21] + (size_t)layer * DFF;
    constexpr int NCH = DFF / 8, NRB = M / 8;
    for (int i = gtid; i < NRB * NCH; i += ngt) {
        const int rb = i / NCH, ch = i - rb * NCH, c0 = ch * 8, m0 = rb * 8;
        const int mp = act_prev_row(m0), mn = act_next_row(m0 + 7);
        const u32x4 z = (u32x4){0u, 0u, 0u, 0u};
        u32x4 g[10], v[8];
        g[0] = mp >= 0 ? *(const u32x4*)(Gb + (size_t)mp * DFF + c0) : z;
#pragma unroll
        for (int r = 0; r < 8; ++r) { g[r + 1] = *(const u32x4*)(Gb + (size_t)(m0 + r) * DFF + c0); v[r] = *(const u32x4*)(Vb + (size_t)(m0 + r) * DFF + c0); }
        g[9] = mn >= 0 ? *(const u32x4*)(Gb + (size_t)mn * DFF + c0) : z;
        float w0[8], w1[8], w2[8], bb[8];
#pragma unroll
        for (int j = 0; j < 8; ++j) { w0[j] = cw[c0 + j]; w1[j] = cw[DFF + c0 + j]; w2[j] = cw[2 * DFF + c0 + j]; bb[j] = cb[c0 + j]; }
#pragma unroll
        for (int r = 0; r < 8; ++r) {
            const unsigned gp[4] = {g[r].x, g[r].y, g[r].z, g[r].w}, gc[4] = {g[r + 1].x, g[r + 1].y, g[r + 1].z, g[r + 1].w}, gn[4] = {g[r + 2].x, g[r + 2].y, g[r + 2].z, g[r + 2].w}, vv[4] = {v[r].x, v[r].y, v[r].z, v[r].w};
            float o[8];
#pragma unroll
            for (int j = 0; j < 4; ++j) {
                const float a0 = lo_f(gp[j]) * w0[2 * j] + lo_f(gc[j]) * w1[2 * j] + lo_f(gn[j]) * w2[2 * j] + bb[2 * j];
                const float a1 = hi_f(gp[j]) * w0[2 * j + 1] + hi_f(gc[j]) * w1[2 * j + 1] + hi_f(gn[j]) * w2[2 * j + 1] + bb[2 * j + 1];
                o[2 * j] = a0 * sigmoid_f(a0) * lo_f(vv[j]); o[2 * j + 1] = a1 * sigmoid_f(a1) * hi_f(vv[j]);
            }
            u32x4 w; w.x = pk2(o[0], o[1]); w.y = pk2(o[2], o[3]); w.z = pk2(o[4], o[5]); w.w = pk2(o[6], o[7]);
            *(u32x4*)(Vb + (size_t)(m0 + r) * DFF + c0) = w;
        }
    }
}

template <int KS>
__device__ __forceinline__ void load_k(bf16x8 (&kf)[KS], const bf16_t* kp) {
#pragma unroll
    for (int ks = 0; ks < KS; ++ks) kf[ks] = *(const bf16x8*)(kp + 32 * ks);
}
template <int KS>
__device__ __forceinline__ f32x4 st_mma(const bf16x8 (&kf)[KS], const bf16x8 (&qf)[KS]) {
    f32x4 s = (f32x4){0.f, 0.f, 0.f, 0.f};
#pragma unroll
    for (int ks = 0; ks < KS; ++ks) s = mfma16(kf[ks], qf[ks], s);
    return s;
}
__device__ __forceinline__ bf16x8 pack_p(const float (&p0)[4], const float (&p1)[4]) {
    u32x4 w; w.x = pk2(p0[0], p0[1]); w.y = pk2(p0[2], p0[3]); w.z = pk2(p1[0], p1[1]); w.w = pk2(p1[2], p1[3]);
    return __builtin_bit_cast(bf16x8, w);
}
template <int NT>
__device__ __forceinline__ void pv_step(f32x4 (&acc)[NT], bf16x8 pf, const bf16_t* v0, const bf16_t* v1) {
    constexpr int GRP = NT < 8 ? NT : 8;
#pragma unroll
    for (int g0 = 0; g0 < NT; g0 += GRP) {
        u32x2 va[GRP], vb[GRP];
#pragma unroll
        for (int i = 0; i < GRP; ++i) { va[i] = *(const u32x2*)(v0 + (size_t)(g0 + i) * 16 * M); vb[i] = *(const u32x2*)(v1 + (size_t)(g0 + i) * 16 * M); }
#pragma unroll
        for (int i = 0; i < GRP; ++i) asm volatile("" : "+v"(va[i]), "+v"(vb[i]));
#pragma unroll
        for (int i = 0; i < GRP; ++i) { u32x4 w; w.x = va[i].x; w.y = va[i].y; w.z = vb[i].x; w.w = vb[i].y; acc[g0 + i] = mfma16(pf, __builtin_bit_cast(bf16x8, w), acc[g0 + i]); }
    }
}

constexpr int MX_KBYTES = 32 * 272, MX_VBYTES = 256 * 80, MX_BUF = MX_KBYTES + MX_VBYTES, MX_FLAG = 2 * MX_BUF;
constexpr size_t BIG_RO = BIG_VT + (size_t)NVT * M * 2;
static_assert(BIG_RO + (size_t)M * 1024 * 2 <= BIG_BYTES, "RO fits");
static_assert(MX_FLAG + 64 <= 131072, "mixer LDS fits");
template <int DK, int DV, bool DIFF>
__device__ __forceinline__ void wg_attn_task(ParamsCP pp, int layer, LAS unsigned char* lds, int b, int h, int qb, int tid) {
    constexpr int KS = DK / 32, NT = DV / 16, KP = DK * 2 + 16, VP = 80, KCH = DK / 8, NV = (DV * 4 + 511) / 512;
    const bf16_t* PROJ = (const bf16_t*)(pp->ws + WS_BIG + BIG_PROJ); const bf16_t* VT = (const bf16_t*)(pp->ws + WS_BIG + BIG_VT);
    const int lane = tid & 63, wave = __builtin_amdgcn_readfirstlane(tid >> 6), c16 = lane & 15, quad = lane >> 4;
    const size_t qcol = DIFF ? PBUF + h * 256 : (size_t)(C_RQ + h * 64);
    const size_t kcol = DIFF ? PBUF + 1024 + h * 256 : (size_t)(C_RK + h * 64);
    const int vrow0 = DIFF ? V_DIFF + h * 256 : V_RET + h * 128;
    const int jraw = qb * 8 + wave; const bool active = jraw < 129; const int jq = active ? jraw : 128;
    const int qrow0 = tile_row(b, jq);
    const bool kcopy = tid < 32 * KCH; const int krow = tid / KCH, kch = tid % KCH;
    float lam = 0.f, cb = 0.f; float lgf = 0.f, lgb = 0.f;
    if (DIFF) { const float* misc = (const float*)(pp->ws + WS_MISC) + 16 * layer; lam = misc[0]; cb = misc[1] * LOG2E; }
    else { lgf = log1pf(-exp2f(-pp->in[4][layer * 8 + h])) * LOG2E; lgb = log1pf(-exp2f(-pp->in[5][layer * 8 + h])) * LOG2E; }
    const float sc = 0.08838834764831845f * LOG2E;
    const int tq = 16 * jq + c16;
    f32x4 O[NT];
#pragma unroll
    for (int e0 = 0; e0 < NT; ++e0) O[e0] = (f32x4){0.f, 0.f, 0.f, 0.f};
#pragma unroll 1
    for (int half = 0; half < (DIFF ? 2 : 1); ++half) {
        bf16x8 qf[KS];
        { const bf16_t* qp = PROJ + (size_t)(qrow0 + c16) * PP + qcol + half * 128 + 8 * quad;
#pragma unroll
            for (int ks = 0; ks < KS; ++ks) qf[ks] = *(const bf16x8*)(qp + 32 * ks); }
        f32x4 acc[NT];
#pragma unroll
        for (int e0 = 0; e0 < NT; ++e0) acc[e0] = (f32x4){0.f, 0.f, 0.f, 0.f};
        float lsum = 0.f;
        const size_t kc = kcol + half * 128 + kch * 8;
        u32x4 kreg = (u32x4){0u, 0u, 0u, 0u}, vreg[NV];
#define MX_ISSUE(step) do { const int jt0_ = 2 * (step), jt1_ = jt0_ + 1 < 129 ? jt0_ + 1 : 128; const int kr0_ = tile_row(b, jt0_), kr1_ = tile_row(b, jt1_); \
            if (kcopy) kreg = *(const u32x4*)(PROJ + (size_t)(krow < 16 ? kr0_ + krow : kr1_ + krow - 16) * PP + kc); \
            _Pragma("unroll") for (int i_ = 0; i_ < NV; ++i_) { const int id_ = tid + 512 * i_, vr_ = id_ >> 2, vc_ = id_ & 3; \
                vreg[i_] = *(const u32x4*)(VT + (size_t)(vrow0 + vr_) * M + ((vc_ < 2 ? kr0_ : kr1_) + (vc_ & 1) * 8)); } } while (0)
#define MX_COMMIT(buf) do { LAS unsigned char* bb_ = lds + (buf) * MX_BUF; \
            if (kcopy) *(LAS u32x4*)(bb_ + krow * KP + kch * 16) = kreg; \
            _Pragma("unroll") for (int i_ = 0; i_ < NV; ++i_) { const int id_ = tid + 512 * i_, vr_ = id_ >> 2, vc_ = id_ & 3; \
                *(LAS u32x4*)(bb_ + MX_KBYTES + vr_ * VP + vc_ * 16) = vreg[i_]; } } while (0)
        __syncthreads();
        MX_ISSUE(0); MX_COMMIT(0);
        __syncthreads();
#pragma unroll 1
        for (int st = 0; st < 65; ++st) {
            const int buf = st & 1;
            if (st + 1 < 65) MX_ISSUE(st + 1);
            const LAS unsigned char* kb = lds + buf * MX_BUF; const LAS unsigned char* vb = kb + MX_KBYTES;
            bf16x8 k0[KS], k1[KS];
#pragma unroll
            for (int ks = 0; ks < KS; ++ks) { k0[ks] = *(const LAS bf16x8*)(kb + c16 * KP + (32 * ks + 8 * quad) * 2); k1[ks] = *(const LAS bf16x8*)(kb + (16 + c16) * KP + (32 * ks + 8 * quad) * 2); }
            const f32x4 s0 = st_mma<KS>(k0, qf), s1 = st_mma<KS>(k1, qf);
            const bool v1 = 2 * st + 1 < 129;
            float p0[4], p1[4];
#pragma unroll
            for (int r = 0; r < 4; ++r) {
                if (DIFF) { p0[r] = fast_exp2(s0[r] * sc - cb); p1[r] = v1 ? fast_exp2(s1[r] * sc - cb) : 0.f; lsum += p0[r] + p1[r]; }
                else { const int d0 = tq - (32 * st + 4 * quad + r), d1 = d0 - 16;
                    p0[r] = s0[r] * fast_exp2(d0 >= 0 ? (float)d0 * lgf : (float)(-d0) * lgb);
                    p1[r] = v1 ? s1[r] * fast_exp2(d1 >= 0 ? (float)d1 * lgf : (float)(-d1) * lgb) : 0.f; }
            }
            const bf16x8 pf = pack_p(p0, p1);
#pragma unroll
            for (int e0 = 0; e0 < NT; ++e0) {
                const u32x2 va = *(const LAS u32x2*)(vb + (e0 * 16 + c16) * VP + 8 * quad), vbb = *(const LAS u32x2*)(vb + (e0 * 16 + c16) * VP + 32 + 8 * quad);
                u32x4 w; w.x = va.x; w.y = va.y; w.z = vbb.x; w.w = vbb.y;
                acc[e0] = mfma16(pf, __builtin_bit_cast(bf16x8, w), acc[e0]);
            }
            if (st + 1 < 65) MX_COMMIT(buf ^ 1);
            __syncthreads();
        }
#undef MX_ISSUE
#undef MX_COMMIT
        if (DIFF) {
            lsum += __shfl_xor(lsum, 16); lsum += __shfl_xor(lsum, 32);
            float il[4];
#pragma unroll
            for (int r = 0; r < 4; ++r) il[r] = 1.0f / __shfl(lsum, 4 * quad + r);
            const float f = half == 0 ? 1.0f : -lam;
#pragma unroll
            for (int e0 = 0; e0 < NT; ++e0)
#pragma unroll
                for (int r = 0; r < 4; ++r) O[e0][r] += f * acc[e0][r] * il[r];
        } else {
#pragma unroll
            for (int e0 = 0; e0 < NT; ++e0) O[e0] = acc[e0];
        }
    }
    if (active) {
        bf16_t* yb = DIFF ? (bf16_t*)(pp->ws + WS_BIG + BIG_PROJ) + PBUF + (size_t)(qrow0 + 4 * quad) * PP + h * 256 + c16
                          : (bf16_t*)(pp->ws + WS_BIG + BIG_RO) + (size_t)(qrow0 + 4 * quad) * 1024 + h * 128 + c16;
        const int pitch = DIFF ? PP : 1024;
#pragma unroll
        for (int e0 = 0; e0 < NT; ++e0)
#pragma unroll
            for (int r = 0; r < 4; ++r) yb[(size_t)r * pitch + e0 * 16] = (bf16_t)f2bf(O[e0][r]);
    }
}
constexpr int DF_KP = 528, DF_KBYTES = 32 * DF_KP, DF_BUF = DF_KBYTES + MX_VBYTES;
static_assert(2 * DF_BUF <= MX_FLAG || 2 * DF_BUF + 64 <= 131072, "diff LDS");
constexpr int DF_FLAG = 2 * DF_BUF;
__device__ __forceinline__ void wg_diff_task(ParamsCP pp, int layer, LAS unsigned char* lds, int b, int h, int qb, int tid_in) {
    constexpr int VP = 80;
    int tid = tid_in; asm volatile("" : "+v"(tid));
    const bf16_t* PROJ = (const bf16_t*)(pp->ws + WS_BIG + BIG_PROJ); const bf16_t* VT = (const bf16_t*)(pp->ws + WS_BIG + BIG_VT);
    const int lane = tid & 63, wave = __builtin_amdgcn_readfirstlane(tid >> 6), c16 = lane & 15, quad = lane >> 4;
    const size_t qcol = PBUF + h * 256, kcol = PBUF + 1024 + h * 256;
    const int vrow0 = V_DIFF + h * 256;
    const int jraw = qb * 8 + wave; const bool active = jraw < 129; const int jq = active ? jraw : 128;
    const int qrow0 = tile_row(b, jq);
    const float* misc = (const float*)(pp->ws + WS_MISC) + 16 * layer;
    const float lam = uniform_f(misc[0]), cb = uniform_f(misc[1] * LOG2E), sc = 0.08838834764831845f * LOG2E;
    bf16x8 qf0[4], qf1[4];
    { const bf16_t* qp = PROJ + (size_t)(qrow0 + c16) * PP + qcol + 8 * quad;
#pragma unroll
        for (int ks = 0; ks < 4; ++ks) { qf0[ks] = *(const bf16x8*)(qp + 32 * ks); qf1[ks] = *(const bf16x8*)(qp + 128 + 32 * ks); } }
    f32x4 acc0[16], acc1[16];
#pragma unroll
    for (int e0 = 0; e0 < 16; ++e0) { acc0[e0] = (f32x4){0.f, 0.f, 0.f, 0.f}; acc1[e0] = (f32x4){0.f, 0.f, 0.f, 0.f}; }
    float ls0 = 0.f, ls1 = 0.f;
    u32x4 kreg[2], vreg[2];
#define DF_ISSUE(step) do { const int jt0_ = 2 * (step), jt1_ = jt0_ + 1 < 129 ? jt0_ + 1 : 128; const int kr0_ = tile_row(b, jt0_), kr1_ = tile_row(b, jt1_); \
        _Pragma("unroll") for (int i_ = 0; i_ < 2; ++i_) { const int id_ = tid + 512 * i_, kr_ = id_ >> 5, kc_ = id_ & 31, vr_ = id_ >> 2, vc_ = id_ & 3; \
            kreg[i_] = *(const u32x4*)(PROJ + (size_t)(kr_ < 16 ? kr0_ + kr_ : kr1_ + kr_ - 16) * PP + kcol + kc_ * 8); \
            vreg[i_] = *(const u32x4*)(VT + (size_t)(vrow0 + vr_) * M + ((vc_ < 2 ? kr0_ : kr1_) + (vc_ & 1) * 8)); } } while (0)
#define DF_COMMIT(buf) do { LAS unsigned char* bb_ = lds + (buf) * DF_BUF; \
        _Pragma("unroll") for (int i_ = 0; i_ < 2; ++i_) { const int id_ = tid + 512 * i_, kr_ = id_ >> 5, kc_ = id_ & 31, vr_ = id_ >> 2, vc_ = id_ & 3; \
            *(LAS u32x4*)(bb_ + kr_ * DF_KP + kc_ * 16) = kreg[i_]; *(LAS u32x4*)(bb_ + DF_KBYTES + vr_ * VP + vc_ * 16) = vreg[i_]; } } while (0)
    __syncthreads();
    DF_ISSUE(0); DF_COMMIT(0);
    __syncthreads();
#pragma unroll 1
    for (int st = 0; st < 65; ++st) {
        const int buf = st & 1;
        if (st + 1 < 65) DF_ISSUE(st + 1);
        const LAS unsigned char* kb = lds + buf * DF_BUF; const LAS unsigned char* vb = kb + DF_KBYTES;
        const bool v1 = 2 * st + 1 < 129;
        bf16x8 pf0, pf1;
        {   bf16x8 k0[4], k1[4];
#pragma unroll
            for (int ks = 0; ks < 4; ++ks) { k0[ks] = *(const LAS bf16x8*)(kb + c16 * DF_KP + (32 * ks + 8 * quad) * 2); k1[ks] = *(const LAS bf16x8*)(kb + (16 + c16) * DF_KP + (32 * ks + 8 * quad) * 2); }
            const f32x4 s0 = st_mma<4>(k0, qf0), s1 = st_mma<4>(k1, qf0);
            float p0[4], p1[4];
#pragma unroll
            for (int r = 0; r < 4; ++r) { p0[r] = fast_exp2(s0[r] * sc - cb); p1[r] = v1 ? fast_exp2(s1[r] * sc - cb) : 0.f; ls0 += p0[r] + p1[r]; }
            pf0 = pack_p(p0, p1); }
        {   bf16x8 k0[4], k1[4];
#pragma unroll
            for (int ks = 0; ks < 4; ++ks) { k0[ks] = *(const LAS bf16x8*)(kb + c16 * DF_KP + 256 + (32 * ks + 8 * quad) * 2); k1[ks] = *(const LAS bf16x8*)(kb + (16 + c16) * DF_KP + 256 + (32 * ks + 8 * quad) * 2); }
            const f32x4 s0 = st_mma<4>(k0, qf1), s1 = st_mma<4>(k1, qf1);
            float p0[4], p1[4];
#pragma unroll
            for (int r = 0; r < 4; ++r) { p0[r] = fast_exp2(s0[r] * sc - cb); p1[r] = v1 ? fast_exp2(s1[r] * sc - cb) : 0.f; ls1 += p0[r] + p1[r]; }
            pf1 = pack_p(p0, p1); }
#pragma unroll
        for (int e0 = 0; e0 < 16; ++e0) {
            const u32x2 va = *(const LAS u32x2*)(vb + (e0 * 16 + c16) * VP + 8 * quad), vbb = *(const LAS u32x2*)(vb + (e0 * 16 + c16) * VP + 32 + 8 * quad);
            u32x4 w; w.x = va.x; w.y = va.y; w.z = vbb.x; w.w = vbb.y; const bf16x8 vf = __builtin_bit_cast(bf16x8, w);
            acc0[e0] = mfma16(pf0, vf, acc0[e0]); acc1[e0] = mfma16(pf1, vf, acc1[e0]);
        }
        if (st + 1 < 65) DF_COMMIT(buf ^ 1);
        __syncthreads();
    }
#undef DF_ISSUE
#undef DF_COMMIT
    ls0 += __shfl_xor(ls0, 16); ls0 += __shfl_xor(ls0, 32); ls1 += __shfl_xor(ls1, 16); ls1 += __shfl_xor(ls1, 32);
    float i0[4], i1[4];
#pragma unroll
    for (int r = 0; r < 4; ++r) { i0[r] = fast_rcp(__shfl(ls0, 4 * quad + r)); i1[r] = lam * fast_rcp(__shfl(ls1, 4 * quad + r)); }
    if (active) {
        bf16_t* yb = (bf16_t*)(pp->ws + WS_BIG + BIG_PROJ) + PBUF + (size_t)(qrow0 + 4 * quad) * PP + h * 256 + c16;
#pragma unroll
        for (int e0 = 0; e0 < 16; ++e0)
#pragma unroll
            for (int r = 0; r < 4; ++r) yb[(size_t)r * PP + e0 * 16] = (bf16_t)f2bf(acc0[e0][r] * i0[r] - acc1[e0][r] * i1[r]);
    }
}
__device__ __forceinline__ void diff_post_phase(ParamsCP pp, int layer, int gw, int ngw, int lane) {
    bf16_t* PD = (bf16_t*)(pp->ws + WS_BIG + BIG_PROJ) + PBUF;
    const float* misc = (const float*)(pp->ws + WS_MISC) + 16 * layer;
    const float cl = 1.0f - misc[3];
    const float* og = pp->in[10] + layer * 256;
    const f32x4 g4 = *(const f32x4*)(og + 4 * lane);
    for (int m = gw; m < M; m += ngw) {
        u32x2 w[4];
#pragma unroll
        for (int h = 0; h < 4; ++h) w[h] = *(const u32x2*)(PD + (size_t)m * PP + h * 256 + 4 * lane);
#pragma unroll
        for (int h = 0; h < 4; ++h) {
            const float a0 = lo_f(w[h].x), a1 = hi_f(w[h].x), a2 = lo_f(w[h].y), a3 = hi_f(w[h].y);
            const float ss = wave_sum((a0 * a0 + a1 * a1) + (a2 * a2 + a3 * a3));
            const float rs = rsqrtf(ss * (1.0f / 256.0f) + EPS) * cl;
            u32x2 o2; o2.x = pk2(a0 * rs * g4.x, a1 * rs * g4.y); o2.y = pk2(a2 * rs * g4.z, a3 * rs * g4.w);
            *(u32x2*)(PD + (size_t)m * PP + h * 256 + 4 * lane) = o2;
        }
    }
}
__device__ __forceinline__ void wg_ret_task(ParamsCP pp, int layer, LAS unsigned char* lds, int b, int h, int qb, int tid_in) {
    constexpr int KP = 144, VP = 80;
    int tid = tid_in; asm volatile("" : "+v"(tid));
    const bf16_t* PROJ = (const bf16_t*)(pp->ws + WS_BIG + BIG_PROJ); const bf16_t* VT = (const bf16_t*)(pp->ws + WS_BIG + BIG_VT);
    const int lane = tid & 63, wave = __builtin_amdgcn_readfirstlane(tid >> 6), c16 = lane & 15, quad = lane >> 4;
    const size_t qcol = C_RQ + h * 64, kcol = C_RK + h * 64;
    const int vrow0 = V_RET + h * 128;
    const int jrA = qb * 16 + wave, jrB = jrA + 8; const bool actA = jrA < 129, actB = jrB < 129; const int jA = actA ? jrA : 128, jB = actB ? jrB : 128;
    const int qrowA = tile_row(b, jA), qrowB = tile_row(b, jB);
    const bool kcopy = tid < 256; const int krow = (tid & 255) >> 3, kch = tid & 7, vr = tid >> 2, vc = tid & 3;
    const float lgf = log1pf(-exp2f(-pp->in[4][layer * 8 + h])) * LOG2E, lgb = log1pf(-exp2f(-pp->in[5][layer * 8 + h])) * LOG2E;
    const int tqA = 16 * jA + c16, tqB = 16 * jB + c16;
    bf16x8 qA[2], qB[2];
    { const bf16_t* qp = PROJ + (size_t)(qrowA + c16) * PP + qcol + 8 * quad; qA[0] = *(const bf16x8*)qp; qA[1] = *(const bf16x8*)(qp + 32);
      const bf16_t* qp2 = PROJ + (size_t)(qrowB + c16) * PP + qcol + 8 * quad; qB[0] = *(const bf16x8*)qp2; qB[1] = *(const bf16x8*)(qp2 + 32); }
    f32x4 accA[8], accB[8];
#pragma unroll
    for (int e0 = 0; e0 < 8; ++e0) { accA[e0] = (f32x4){0.f, 0.f, 0.f, 0.f}; accB[e0] = (f32x4){0.f, 0.f, 0.f, 0.f}; }
    u32x4 kr0s = (u32x4){0u, 0u, 0u, 0u}, vr0s = kr0s, kr1s = kr0s, vr1s = kr0s;
#define RT_ISSUE(KR, VR, step) do { const int s_ = (step) < 65 ? (step) : 64; const int jt0_ = 2 * s_, jt1_ = jt0_ + 1 < 129 ? jt0_ + 1 : 128; const int a0_ = tile_row(b, jt0_), a1_ = tile_row(b, jt1_); \
        if (kcopy) KR = *(const u32x4*)(PROJ + (size_t)(krow < 16 ? a0_ + krow : a1_ + krow - 16) * PP + kcol + kch * 8); \
        VR = *(const u32x4*)(VT + (size_t)(vrow0 + vr) * M + ((vc < 2 ? a0_ : a1_) + (vc & 1) * 8)); } while (0)
#define RT_COMMIT(KR, VR, buf) do { LAS unsigned char* bb_ = lds + (buf) * MX_BUF; \
        if (kcopy) *(LAS u32x4*)(bb_ + krow * KP + kch * 16) = KR; *(LAS u32x4*)(bb_ + MX_KBYTES + vr * VP + vc * 16) = VR; } while (0)
#define RT_COMPUTE(st, buf) do { const LAS unsigned char* kb = lds + (buf) * MX_BUF; const LAS unsigned char* vb = kb + MX_KBYTES; \
        bf16x8 k0[2], k1[2]; \
        _Pragma("unroll") for (int ks = 0; ks < 2; ++ks) { k0[ks] = *(const LAS bf16x8*)(kb + c16 * KP + (32 * ks + 8 * quad) * 2); k1[ks] = *(const LAS bf16x8*)(kb + (16 + c16) * KP + (32 * ks + 8 * quad) * 2); } \
        const f32x4 sA0 = st_mma<2>(k0, qA), sA1 = st_mma<2>(k1, qA), sB0 = st_mma<2>(k0, qB), sB1 = st_mma<2>(k1, qB); \
        const bool v1 = 2 * (st) + 1 < 129; float pa0[4], pa1[4], pb0[4], pb1[4]; \
        _Pragma("unroll") for (int r = 0; r < 4; ++r) { const int tk = 32 * (st) + 4 * quad + r; \
            const int dA0 = tqA - tk, dA1 = dA0 - 16, dB0 = tqB - tk, dB1 = dB0 - 16; \
            pa0[r] = sA0[r] * fast_exp2(dA0 >= 0 ? (float)dA0 * lgf : (float)(-dA0) * lgb); \
            pa1[r] = v1 ? sA1[r] * fast_exp2(dA1 >= 0 ? (float)dA1 * lgf : (float)(-dA1) * lgb) : 0.f; \
            pb0[r] = sB0[r] * fast_exp2(dB0 >= 0 ? (float)dB0 * lgf : (float)(-dB0) * lgb); \
            pb1[r] = v1 ? sB1[r] * fast_exp2(dB1 >= 0 ? (float)dB1 * lgf : (float)(-dB1) * lgb) : 0.f; } \
        const bf16x8 pfA = pack_p(pa0, pa1), pfB = pack_p(pb0, pb1); \
        _Pragma("unroll") for (int e0 = 0; e0 < 8; ++e0) { \
            const u32x2 va = *(const LAS u32x2*)(vb + (e0 * 16 + c16) * VP + 8 * quad), vbb = *(const LAS u32x2*)(vb + (e0 * 16 + c16) * VP + 32 + 8 * quad); \
            u32x4 w; w.x = va.x; w.y = va.y; w.z = vbb.x; w.w = vbb.y; const bf16x8 vf = __builtin_bit_cast(bf16x8, w); \
            accA[e0] = mfma16(pfA, vf, accA[e0]); accB[e0] = mfma16(pfB, vf, accB[e0]); } } while (0)
    __syncthreads();
    RT_ISSUE(kr0s, vr0s, 0); RT_COMMIT(kr0s, vr0s, 0); RT_ISSUE(kr1s, vr1s, 1);
    __syncthreads();
#pragma unroll 1
    for (int st = 0; st < 65; st += 2) {
        RT_ISSUE(kr0s, vr0s, st + 2); RT_COMPUTE(st, 0); RT_COMMIT(kr1s, vr1s, 1); __syncthreads();
        if (st + 1 < 65) { RT_ISSUE(kr1s, vr1s, st + 3); RT_COMPUTE(st + 1, 1); RT_COMMIT(kr0s, vr0s, 0); __syncthreads(); }
    }
#undef RT_ISSUE
#undef RT_COMMIT
#undef RT_COMPUTE
    bf16_t* ro = (bf16_t*)(pp->ws + WS_BIG + BIG_RO);
    if (actA) { bf16_t* yb = ro + (size_t)(qrowA + 4 * quad) * 1024 + h * 128 + c16;
#pragma unroll
        for (int e0 = 0; e0 < 8; ++e0)
#pragma unroll
            for (int r = 0; r < 4; ++r) yb[(size_t)r * 1024 + e0 * 16] = (bf16_t)f2bf(accA[e0][r]); }
    if (actB) { bf16_t* yb = ro + (size_t)(qrowB + 4 * quad) * 1024 + h * 128 + c16;
#pragma unroll
        for (int e0 = 0; e0 < 8; ++e0)
#pragma unroll
            for (int r = 0; r < 4; ++r) yb[(size_t)r * 1024 + e0 * 16] = (bf16_t)f2bf(accB[e0][r]); }
}
__device__ __forceinline__ void ret_post_phase(ParamsCP pp, int layer, int gw, int ngw, int lane) {
    bf16_t* PR = (bf16_t*)(pp->ws + WS_BIG + BIG_PROJ); const bf16_t* RO = (const bf16_t*)(pp->ws + WS_BIG + BIG_RO);
    const float* og = pp->in[6] + layer * 1024;
    float o0[8], o1[8];
#pragma unroll
    for (int h = 0; h < 8; ++h) { o0[h] = og[h * 128 + 2 * lane]; o1[h] = og[h * 128 + 2 * lane + 1]; }
    for (int m = gw; m < M; m += ngw) {
        unsigned w[8], gv[8];
#pragma unroll
        for (int h = 0; h < 8; ++h) { w[h] = *(const unsigned*)(RO + (size_t)m * 1024 + h * 128 + 2 * lane); gv[h] = *(const unsigned*)(PR + (size_t)m * PP + C_RG + h * 128 + 2 * lane); }
#pragma unroll
        for (int h = 0; h < 8; ++h) {
            const float a0 = lo_f(w[h]), a1 = hi_f(w[h]), g0 = lo_f(gv[h]), g1 = hi_f(gv[h]);
            const float ss = wave_sum(a0 * a0 + a1 * a1);
            const float rs = rsqrtf(ss * (1.0f / 128.0f) + EPS);
            *(unsigned*)(PR + (size_t)m * PP + C_RG + h * 128 + 2 * lane) = pk2(a0 * rs * o0[h] * g0 * sigmoid_f(g0), a1 * rs * o1[h] * g1 * sigmoid_f(g1));
        }
    }
}

__device__ __forceinline__ void na_task(ParamsCP pp, int layer, int b, int h, int r, int g, int lane_in) {
    int lane = lane_in; asm volatile("" : "+v"(lane));
    const bf16_t* PROJ = (const bf16_t*)(pp->ws + WS_BIG + BIG_PROJ); const bf16_t* VT = (const bf16_t*)(pp->ws + WS_BIG + BIG_VT);
    const float* misc = (const float*)(pp->ws + WS_MISC) + 16 * layer;
    const float bound = misc[2];
    const float* rpb = pp->in[13] + (size_t)layer * 7440 + (size_t)h * 465;
    const int c16 = lane & 15, quad = lane >> 4;
    const bool meta = r < 0;
    const int qrow0 = meta ? b * 16 : RB + b * SEQ + r * 64 + 16 * g;
    bf16x8 qf[2];
    { const bf16_t* qp = PROJ + 2 * PBUF + (size_t)(qrow0 + c16) * PP + h * 64 + 8 * quad; qf[0] = *(const bf16x8*)qp; qf[1] = *(const bf16x8*)(qp + 32); }
    f32x4 acc[4];
#pragma unroll
    for (int e0 = 0; e0 < 4; ++e0) acc[e0] = (f32x4){0.f, 0.f, 0.f, 0.f};
    float lsum = 0.f;
    const size_t colk = 2 * PBUF + 1024 + h * 64 + 8 * quad;
    const bf16_t* vbase = VT + (size_t)(V_NA + h * 64 + c16) * M + 4 * quad;
    const int qc = 16 * g + c16;
    int cstart = qc - 8; cstart = cstart < 0 ? 0 : (cstart > 48 ? 48 : cstart);
    int rs = r - 4; rs = rs < 0 ? 0 : (rs > 24 ? 24 : rs);
    int cw0 = 16 * g - 8; cw0 = cw0 < 0 ? 0 : (cw0 > 32 ? 32 : cw0);
    int bi0[4], bi1[4]; bool ok0[4], ok1[4];
#pragma unroll
    for (int rr = 0; rr < 4; ++rr) { const int kc0 = cw0 + 4 * quad + rr, kc1 = kc0 + 16;
        int i0 = kc0 - qc + 15; i0 = i0 < 0 ? 0 : (i0 > 30 ? 30 : i0); int i1 = kc1 - qc + 15; i1 = i1 < 0 ? 0 : (i1 > 30 ? 30 : i1);
        bi0[rr] = i0; bi1[rr] = i1; ok0[rr] = kc0 >= cstart && kc0 < cstart + 16; ok1[rr] = kc1 >= cstart && kc1 < cstart + 16; }
    bf16x8 ck0[2], ck1[2], nk0[2], nk1[2]; u32x2 cva[4], cvb[4], nva[4], nvb[4]; float cb0[4], cb1[4], nb0[4], nb1[4];
#define NA_LOAD(K0, K1, VA, VB, B0, B1, s_) do { const bool win_ = (s_) < 8; const int kr0_ = win_ ? RB + b * SEQ + (rs + (s_)) * 64 + cw0 : b * 16; const int kr1_ = win_ ? kr0_ + 16 : kr0_; \
        load_k<2>(K0, PROJ + (size_t)(kr0_ + c16) * PP + colk); load_k<2>(K1, PROJ + (size_t)(kr1_ + c16) * PP + colk); \
        _Pragma("unroll") for (int e_ = 0; e_ < 4; ++e_) { VA[e_] = *(const u32x2*)(vbase + kr0_ + (size_t)e_ * 16 * M); VB[e_] = *(const u32x2*)(vbase + kr1_ + (size_t)e_ * 16 * M); } \
        const float* brow_ = rpb + (win_ ? (rs + (s_) - r + 7) * 31 : 0); \
        _Pragma("unroll") for (int rr_ = 0; rr_ < 4; ++rr_) { B0[rr_] = brow_[bi0[rr_]]; B1[rr_] = brow_[bi1[rr_]]; } } while (0)
    const int sfirst = meta ? 8 : 0;
    NA_LOAD(ck0, ck1, cva, cvb, cb0, cb1, sfirst);
#pragma unroll 1
    for (int s = sfirst; s < 9; ++s) {
        const bool win = s < 8;
        if (s + 1 < 9) NA_LOAD(nk0, nk1, nva, nvb, nb0, nb1, s + 1);
        asm volatile("" ::: "memory");
        const f32x4 s0 = st_mma<2>(ck0, qf), s1 = st_mma<2>(ck1, qf);
        float p0[4], p1[4];
#pragma unroll
        for (int rr = 0; rr < 4; ++rr) {
            if (win) { p0[rr] = ok0[rr] ? fast_exp2((s0[rr] * 0.125f + cb0[rr] - bound) * LOG2E) : 0.f; p1[rr] = ok1[rr] ? fast_exp2((s1[rr] * 0.125f + cb1[rr] - bound) * LOG2E) : 0.f; }
            else { p0[rr] = fast_exp2((s0[rr] * 0.125f - bound) * LOG2E); p1[rr] = 0.f; }
            lsum += p0[rr] + p1[rr];
        }
        const bf16x8 pf = pack_p(p0, p1);
#pragma unroll
        for (int e0 = 0; e0 < 4; ++e0) { u32x4 w; w.x = cva[e0].x; w.y = cva[e0].y; w.z = cvb[e0].x; w.w = cvb[e0].y; acc[e0] = mfma16(pf, __builtin_bit_cast(bf16x8, w), acc[e0]); }
#pragma unroll
        for (int i = 0; i < 2; ++i) { ck0[i] = nk0[i]; ck1[i] = nk1[i]; }
#pragma unroll
        for (int i = 0; i < 4; ++i) { cva[i] = nva[i]; cvb[i] = nvb[i]; cb0[i] = nb0[i]; cb1[i] = nb1[i]; }
    }
#undef NA_LOAD
    lsum += __shfl_xor(lsum, 16); lsum += __shfl_xor(lsum, 32);
    float il[4];
#pragma unroll
    for (int rr = 0; rr < 4; ++rr) il[rr] = 1.0f / __shfl(lsum, 4 * quad + rr);
    bf16_t* yb = (bf16_t*)(pp->ws + WS_BIG + BIG_PROJ) + 2 * PBUF + (size_t)(qrow0 + 4 * quad) * PP + h * 64 + c16;
#pragma unroll
    for (int e0 = 0; e0 < 4; ++e0)
#pragma unroll
        for (int rr = 0; rr < 4; ++rr) yb[(size_t)rr * PP + e0 * 16] = (bf16_t)f2bf(acc[e0][rr] * il[rr]);
}

constexpr int TW_DIFF = NBATCH * 4 * 17, TW_RET = NBATCH * 8 * 9, TW_TOTAL = TW_DIFF + TW_RET;
constexpr int T_NA = NBATCH * 16 * 128, T_NAM = NBATCH * 16, T_NATOTAL = T_NA + T_NAM;
__device__ __forceinline__ void mixer_phase(ParamsCP pp, int layer, LAS unsigned char* lds, int tid) {
    unsigned* ctrw = (unsigned*)(pp->ws + WS_CTL) + 64 * layer; unsigned* ctrn = ctrw + 128;
    const int lane = tid & 63;
    LAS unsigned* flag = (LAS unsigned*)(lds + DF_FLAG);
    for (;;) {
        __syncthreads();
        if (tid == 0) *flag = atomicAdd(ctrw, 1u);
        __syncthreads();
        const int q = (int)__builtin_amdgcn_readfirstlane((int)*flag);
        if (q >= TW_TOTAL) break;
        if (q < TW_DIFF) { const int b = q / 68, rem = q - b * 68, h = rem / 17, qb = rem - h * 17; wg_diff_task(pp, layer, lds, b, h, qb, tid); }
        else { const int q2 = q - TW_DIFF; const int b = q2 / 72, rem = q2 - b * 72, h = rem / 9, qb = rem - h * 9; wg_ret_task(pp, layer, lds, b, h, qb, tid); }
    }
    for (;;) {
        unsigned t = 0;
        if (lane == 0) t = atomicAdd(ctrn, 1u);
        t = (unsigned)__builtin_amdgcn_readfirstlane((int)t);
        if (t >= (unsigned)T_NATOTAL) break;
        int q = (int)t;
        if (q < T_NA) { const int b = q >> 11, rem = q & 2047, h = rem >> 7, rg = rem & 127; na_task(pp, layer, b, h, rg >> 2, rg & 3, lane); continue; }
        q -= T_NA;
        na_task(pp, layer, q >> 4, q & 15, -1, 0, lane);
    }
}

#define XB_TMO      128
#define XB_XCNT(j)  (256  + 64 * (j))
#define XB_XSUB(j)  (1280 + 64 * (j))
#define XB_XGEN(j)  (2304 + 64 * (j))
#define XB_TOP      3328
#define XB_TOPGEN   3392
#define XCD_BAR_WORDS 3456
#define XB_SPIN_CAP (1u << 18)
constexpr int CW_BAR = 1024;
static_assert((CW_BAR + XCD_BAR_WORDS) * 4 <= (int)CTL_BYTES, "barrier words inside the memset region");
__device__ __forceinline__ unsigned xb_ld(unsigned* p)              { return __hip_atomic_load(p, __ATOMIC_RELAXED, __HIP_MEMORY_SCOPE_AGENT); }
__device__ __forceinline__ unsigned xb_add(unsigned* p, unsigned v) { return __hip_atomic_fetch_add(p, v, __ATOMIC_RELAXED, __HIP_MEMORY_SCOPE_AGENT); }
__device__ __forceinline__ unsigned xb_xcc_id() { return (unsigned)__builtin_amdgcn_s_getreg((3 << 11) | 20) & 0xFu; }
#define XB_SPIN(cond, bar) do { unsigned _sp = 0; while (cond) { __builtin_amdgcn_s_sleep(1); \
    if ((++_sp & 255u) == 0u) { if (xb_ld(&(bar)[XB_TMO])) break; if (_sp > XB_SPIN_CAP) { atomicAdd(&(bar)[XB_TMO], 1u); break; } } } } while (0)
struct XcdBarrier { unsigned* bar; unsigned x; volatile LAS unsigned* st; };
__device__ __forceinline__ XcdBarrier xcd_barrier_post(unsigned* bar, volatile LAS unsigned* st) {
    XcdBarrier b; b.bar = bar; b.x = xb_xcc_id(); b.st = st;
    if (threadIdx.x == 0) (void)xb_add(&bar[XB_XCNT(b.x)], 1u);
    return b;
}
__device__ __forceinline__ void xcd_barrier_complete(unsigned* bar, unsigned x, unsigned& nloc, unsigned& nx) {
    const unsigned G = gridDim.x * gridDim.y * gridDim.z;
    unsigned sum, cnt, mine, sp = 0u;
    for (;;) {
        sum = 0u; cnt = 0u; mine = 0u;
#pragma unroll
        for (unsigned j = 0; j < 16; ++j) { const unsigned c = xb_ld(&bar[XB_XCNT(j)]); sum += c; cnt += (c > 0u) ? 1u : 0u; mine = (j == x) ? c : mine; }
        if (sum == G) break;
        __builtin_amdgcn_s_sleep(1);
        if ((++sp & 255u) == 0u) { if (xb_ld(&bar[XB_TMO])) break; if (sp > XB_SPIN_CAP) { atomicAdd(&bar[XB_TMO], 1u); break; } }
    }
    nloc = mine > 0u ? mine : 1u; nx = cnt > 0u ? cnt : 1u;
}
__device__ __forceinline__ void xcd_barrier(const XcdBarrier& b) {
    asm volatile("s_waitcnt vmcnt(0)" ::: "memory");
    __syncthreads();
    if (threadIdx.x == 0) {
        unsigned* bar = b.bar;
        __builtin_amdgcn_s_waitcnt(0);
        unsigned nloc = b.st[0], nx = b.st[1];
        if (nloc == 0u) { xcd_barrier_complete(bar, b.x, nloc, nx); b.st[0] = nloc; b.st[1] = nx; }
        const unsigned old = xb_add(&bar[XB_XSUB(b.x)], 1u);
        const unsigned gen = old / nloc;
        if (old + 1u == (gen + 1u) * nloc) {
            __builtin_amdgcn_fence(__ATOMIC_RELEASE, "agent");
            asm volatile("s_waitcnt vmcnt(0)" ::: "memory");
            const unsigned og = xb_add(&bar[XB_TOP], 1u);
            const unsigned tg = og / nx;
            if (og + 1u == (tg + 1u) * nx) xb_add(&bar[XB_TOPGEN], 1u);
            else XB_SPIN(xb_ld(&bar[XB_TOPGEN]) == tg, bar);
            __builtin_amdgcn_fence(__ATOMIC_ACQUIRE, "agent");
            xb_add(&bar[XB_XGEN(b.x)], 1u);
            asm volatile("s_waitcnt vmcnt(0)" ::: "memory");
        } else {
            XB_SPIN(xb_ld(&bar[XB_XGEN(b.x)]) == gen, bar);
            __builtin_amdgcn_fence(__ATOMIC_ACQUIRE, "agent");
            asm volatile("s_waitcnt vmcnt(0)" ::: "memory");
        }
    }
    __syncthreads();
}
__global__ void __launch_bounds__(512) fwd_kernel(Params p_unused) {
    extern __shared__ __attribute__((aligned(16))) unsigned char lds_raw[];
    LAS unsigned char* lds = (LAS unsigned char*)lds_raw;
    cg::grid_group grid = cg::this_grid();
    const int G = gridDim.x, blk = blockIdx.x;
    const int ngw = G * 8, ngt = G * 512;
    {
        volatile LAS unsigned* xst = (volatile LAS unsigned*)(lds + 131072 + 64);
        if (threadIdx.x == 0) { xst[0] = 0u; xst[1] = 0u; }
        __syncthreads();
        (void)xcd_barrier_post((unsigned*)(get_params()->ws + WS_CTL) + CW_BAR, xst);
        grid.sync();
    }
#define GRID_SYNC() do { asm volatile("s_waitcnt vmcnt(0) lgkmcnt(0)" ::: "memory"); { XcdBarrier xb_; xb_.bar = (unsigned*)(get_params()->ws + WS_CTL) + CW_BAR; xb_.x = xb_xcc_id(); xb_.st = (volatile LAS unsigned*)(lds + 131072 + 64); xcd_barrier(xb_); } asm volatile("" ::: "memory"); } while (0)
#define FRESH_IDS() int tid = threadIdx.x; asm volatile("" : "+v"(tid)); const int lane = tid & 63, wave = __builtin_amdgcn_readfirstlane(tid >> 6), gw = blk * 8 + wave, gtid = blk * 512 + tid; (void)lane; (void)gw; (void)gtid

    { unsigned* ctl0 = (unsigned*)(get_params()->ws + WS_CTL);
      if (blk == 0 && threadIdx.x < 4) __hip_atomic_store(ctl0 + 64 * threadIdx.x, 0u, __ATOMIC_RELAXED, __HIP_MEMORY_SCOPE_AGENT); }
#pragma unroll 1
    for (int layer = 0; layer < 2; ++layer) {
        { FRESH_IDS(); ParamsCP pp = get_params(); convert_weights(pp, layer, lds, gw, ngw, wave, lane, layer == 0 ? 0 : CW_NITEMS - CW_I_DN, CW_NITEMS); }
        if (layer == 0) { FRESH_IDS(); ParamsCP pp = get_params(); setup_phase(pp, gtid, ngt, gw, lane); }
        { FRESH_IDS(); ParamsCP pp = get_params(); norm_phase(pp, pp->in[2] + layer * D, layer == 0, gw, ngw, lane); }
        GRID_SYNC();
        { FRESH_IDS(); ParamsCP pp = get_params(); unsigned char* ws = pp->ws;
          SchedIn S{(const char*)(ws + WS_U), (const char*)(ws + WS_WT + WT_IN), G, blk}; EpiIn E{(bf16_t*)(ws + WS_BIG + BIG_PROJ), (bf16_t*)(ws + WS_BIG + BIG_VT), (bf16_t*)(ws + WS_GATEM)}; pg8::gemm_phase(lds, S, E, tid); }
        GRID_SYNC();
        { FRESH_IDS(); ParamsCP pp = get_params(); prep_phase(pp, layer, gw, ngw, lane); }
        GRID_SYNC();
        { FRESH_IDS(); ParamsCP pp = get_params(); mixer_phase(pp, layer, lds, tid); }
        GRID_SYNC();
        { FRESH_IDS(); ParamsCP pp = get_params(); diff_post_phase(pp, layer, gw, ngw, lane); ret_post_phase(pp, layer, gw, ngw, lane); }
        GRID_SYNC();
#pragma unroll 1
        for (int br = 0; br < 3; ++br) {
            { FRESH_IDS(); ParamsCP pp = get_params(); unsigned char* ws = pp->ws;
              SchedPlain S{(const char*)(ws + WS_U), (const char*)(ws + WS_WT + WT_IN + (size_t)(9216 + br * 2048) * 4096), 4096u, 4096u, 32, 128, 8, 1, G, blk};
              EpiGate E{(bf16_t*)(ws + WS_BIG + BIG_GATE)}; pg8::gemm_phase(lds, S, E, tid); }
            GRID_SYNC();
            { FRESH_IDS(); ParamsCP pp = get_params(); unsigned char* ws = pp->ws;
              const size_t yoff = ((size_t)br * PBUF + (br == 0 ? 1024 : 0)) * 2;
              SchedPlain S{(const char*)(ws + WS_BIG + BIG_PROJ + yoff), (const char*)(ws + WS_WT + WT_BR + (size_t)br * 2048 * 4096), 4096u, 4096u, 16, 129, 8, 0, G, blk};
              EpiYM E{(const bf16_t*)(ws + WS_BIG + BIG_GATE), (bf16_t*)(ws + WS_BIG + BIG_MERGED), br == 0 ? 1 : 0, (const bf16_t*)(ws + WS_GATEM) + (size_t)br * 256 * D}; pg8::gemm_phase(lds, S, E, tid); }
            GRID_SYNC();
        }
        { FRESH_IDS(); ParamsCP pp = get_params(); unsigned char* ws = pp->ws; float* hmeta = (float*)(ws + WS_HMETA);
          SchedPlain S{(const char*)(ws + WS_BIG + BIG_MERGED), (const char*)(ws + WS_WT + WT_OUT), 4096u, 4096u, 32, 128, 8, 1, G, blk};
          EpiResid E{layer == 0 ? pp->in[0] : (const float*)pp->out, hmeta, pp->out, hmeta}; pg8::gemm_phase(lds, S, E, tid); }
        GRID_SYNC();
        { FRESH_IDS(); ParamsCP pp = get_params(); unsigned char* ws = pp->ws; float* hmeta = (float*)(ws + WS_HMETA);
          if (blk < 8) { SchedPlain S{(const char*)(ws + WS_BIG + BIG_MERGED), (const char*)(ws + WS_WT + WT_OUT), 4096u, 4096u, 32, 1, 8, 0, 8, blk};
                         EpiResid E{layer == 0 ? pp->in[0] : (const float*)pp->out, hmeta, pp->out, hmeta}; pg8::gemm_phase(lds, S, E, tid); }
          else norm_phase(pp, pp->in[18] + layer * D, false, (blk - 8) * 8 + wave, (G - 8) * 8, lane, RB, M); }
        GRID_SYNC();
        { FRESH_IDS(); ParamsCP pp = get_params(); norm_phase(pp, pp->in[18] + layer * D, false, gw, ngw, lane, 0, RB); }
        GRID_SYNC();
        { FRESH_IDS(); ParamsCP pp = get_params(); unsigned char* ws = pp->ws;
          SchedPlain S{(const char*)(ws + WS_U), (const char*)(ws + WS_WT + WT_UP), 4096u, 4096u, 32, 129, 43, 0, G, blk};
          EpiUp E{(bf16_t*)(ws + WS_BIG + BIG_G), (bf16_t*)(ws + WS_BIG + BIG_V)}; pg8::gemm_phase(lds, S, E, tid); }
        GRID_SYNC();
        { FRESH_IDS(); ParamsCP pp = get_params(); act_phase(pp, layer, gtid, ngt); }
        GRID_SYNC();
        { FRESH_IDS(); ParamsCP pp = get_params(); unsigned char* ws = pp->ws; float* hmeta = (float*)(ws + WS_HMETA);
          SchedPlain S{(const char*)(ws + WS_BIG + BIG_V), (const char*)(ws + WS_WT + WT_DOWN), (unsigned)(DFF * 2), (unsigned)(DFF * 2), DFF / 64, 128, 8, 1, G, blk};
          EpiResid E{(const float*)pp->out, hmeta, pp->out, hmeta}; pg8::gemm_phase(lds, S, E, tid); }
        if (layer == 0) {
            GRID_SYNC();
            { FRESH_IDS(); ParamsCP pp = get_params(); unsigned char* ws = pp->ws; float* hmeta = (float*)(ws + WS_HMETA);
              if (blk < 8) { SchedPlain S{(const char*)(ws + WS_BIG + BIG_V), (const char*)(ws + WS_WT + WT_DOWN), (unsigned)(DFF * 2), (unsigned)(DFF * 2), DFF / 64, 1, 8, 0, 8, blk};
                             EpiResid E{(const float*)pp->out, hmeta, pp->out, hmeta}; pg8::gemm_phase(lds, S, E, tid); }
              else convert_weights(pp, 1, lds, (blk - 8) * 8 + wave, (G - 8) * 8, wave, lane, 0, CW_NITEMS - CW_I_DN); }
            GRID_SYNC();
        }
    }
}

constexpr int LDS_BYTES = 131072 + 4096;
extern "C" void kernel_launch(void* const* d_in, const int* in_sizes, int n_in, void* d_out, int out_size, void* d_ws, size_t ws_size, hipStream_t stream) {
    static int grid = 0;
    if (grid == 0) {
        if (n_in != 23 || ws_size < WS_END) { fprintf(stderr, "kernel_launch: need 23 inputs and >= %zu bytes of workspace (got %d, %zu)\n", (size_t)WS_END, n_in, ws_size); grid = -1; return; }
        int dev = 0, cus = 0, per_cu = 0;
        hipGetDevice(&dev);
        hipDeviceGetAttribute(&cus, hipDeviceAttributeMultiprocessorCount, dev);
        if (hipFuncSetAttribute((const void*)fwd_kernel, hipFuncAttributeMaxDynamicSharedMemorySize, LDS_BYTES) != hipSuccess) { fprintf(stderr, "kernel_launch: hipFuncSetAttribute failed\n"); grid = -1; return; }
        if (hipOccupancyMaxActiveBlocksPerMultiprocessor(&per_cu, (const void*)fwd_kernel, 512, LDS_BYTES) != hipSuccess || per_cu < 1) { fprintf(stderr, "kernel_launch: occupancy query failed (%d)\n", per_cu); per_cu = 1; }
        (void)hipGetLastError();
        grid = cus * per_cu; if (grid > 256) grid = 256;
    }
    if (grid < 0) return;
    hipMemsetAsync((char*)d_ws + WS_CTL, 0, CTL_BYTES, stream);
    Params p{};
    for (int i = 0; i < 23; ++i) p.in[i] = (const float*)d_in[i];
    p.out = (float*)d_out; p.ws = (unsigned char*)d_ws;
    void* args[] = {&p};
    hipError_t e = hipLaunchCooperativeKernel((const void*)fwd_kernel, dim3(grid), dim3(512), args, LDS_BYTES, stream);
    if (e != hipSuccess) fprintf(stderr, "cooperative launch failed: %s (grid %d)\n", hipGetErrorString(e), grid);
}
```

```cpp
#include <hip/hip_runtime.h>
#include <hip/hip_cooperative_groups.h>
#include <cstdio>
#include <cstdint>
namespace cg = cooperative_groups;

#define LAS __attribute__((address_space(3)))
typedef unsigned short bf16_t;
typedef short bf16x8 __attribute__((ext_vector_type(8)));
typedef short bf16x4 __attribute__((ext_vector_type(4)));
typedef float f32x4 __attribute__((ext_vector_type(4)));
typedef unsigned u32x4 __attribute__((ext_vector_type(4)));
typedef unsigned u32x2 __attribute__((ext_vector_type(2)));

constexpr int D = 2048, NBATCH = 16, SEQ = 2048, NMETA = 16, LTOK = 2064;
constexpr int M = 33024;
constexpr int RB = 256;
constexpr int NPROJ = 6144;
constexpr int PP = 2048;
constexpr size_t PBUF = (size_t)M * PP;
constexpr int NVT = 3072;
constexpr int NIN = 15360, DFF = 5504;
constexpr int C_RQ = 0, C_RK = 512, C_RG = 1024, C_DQ = 2048, C_DK = 3072, C_NQ = 4096, C_NK = 5120;
constexpr int V_RET = 0, V_DIFF = 1024, V_NA = 2048;
constexpr float EPS = 1e-6f;
constexpr float LOG2E = 1.4426950408889634f;

constexpr size_t WS_CTL = 0;
constexpr size_t CTL_BYTES = 32768;
constexpr size_t WS_MISC = 32768;
constexpr size_t WS_ROPE64 = 65536;
constexpr size_t WS_ROPE128 = WS_ROPE64 + (size_t)LTOK * 32 * 8;
constexpr size_t WS_HMETA = 2u << 20;
constexpr size_t WS_GATEM = 4u << 20;
constexpr size_t WS_WT = 8u << 20;
constexpr size_t WT_IN = 0;
constexpr size_t WT_BR = WT_IN + (size_t)NIN * D * 2;
constexpr size_t WT_OUT = WT_BR + (size_t)3 * D * 2048 * 2;
constexpr size_t WT_UP = WT_OUT + (size_t)D * D * 2;
constexpr size_t WT_DOWN = WT_UP + (size_t)2 * DFF * D * 2;
constexpr size_t WT_BYTES = WT_DOWN + (size_t)D * DFF * 2;
constexpr size_t WS_U = WS_WT + WT_BYTES;
constexpr size_t WS_BIG = WS_U + (size_t)M * D * 2;
constexpr size_t BIG_PROJ = 0;
constexpr size_t BIG_VT = (size_t)M * NPROJ * 2;
constexpr size_t BIG_MERGED = BIG_VT;
constexpr size_t BIG_GATE = BIG_MERGED + (size_t)M * D * 2;
constexpr size_t BIG_G = 0;
constexpr size_t BIG_V = (size_t)M * DFF * 2;
constexpr size_t BIG_BYTES = (size_t)2 * M * DFF * 2;
constexpr size_t WS_END = WS_BIG + BIG_BYTES;
static_assert(BIG_GATE + (size_t)M * D * 2 <= BIG_BYTES, "merged + gate buffers fit behind PROJ");
static_assert(BIG_VT + (size_t)NVT * M * 2 <= BIG_BYTES, "mixer buffers fit");
static_assert(WS_ROPE128 + (size_t)LTOK * 64 * 8 <= WS_HMETA, "rope tables");

struct Params {
    const float* in[23];
    float* out;
    unsigned char* ws;
};
typedef const Params __attribute__((address_space(4)))* ParamsCP;
__device__ __forceinline__ ParamsCP get_params() { ParamsCP q = (ParamsCP)__builtin_amdgcn_kernarg_segment_ptr(); asm volatile("" : "+s"(q)); return q; }

__device__ __forceinline__ float bf2f(unsigned short b) { return __uint_as_float(((unsigned)b) << 16); }
typedef __bf16 bf16x2_t __attribute__((ext_vector_type(2)));
typedef float f32x2_t __attribute__((ext_vector_type(2)));
__device__ __forceinline__ unsigned pk2(float lo, float hi) { f32x2_t v = {lo, hi}; bf16x2_t b = __builtin_convertvector(v, bf16x2_t); return __builtin_bit_cast(unsigned, b); }
__device__ __forceinline__ unsigned f2bf(float f) { return pk2(f, 0.f) & 0xffffu; }
__device__ __forceinline__ float lo_f(unsigned w) { return __uint_as_float(w << 16); }
__device__ __forceinline__ float hi_f(unsigned w) { return __uint_as_float(w & 0xffff0000u); }
__device__ __forceinline__ unsigned cvt_pk_bf16(float lo, float hi) { return pk2(lo, hi); }
__device__ __forceinline__ float wave_sum(float v) {
#pragma unroll
    for (int o = 1; o < 64; o <<= 1) v += __shfl_xor(v, o);
    return v;
}
__device__ __forceinline__ float wave_max(float v) {
#pragma unroll
    for (int o = 1; o < 64; o <<= 1) v = fmaxf(v, __shfl_xor(v, o));
    return v;
}
__device__ __forceinline__ float fast_exp2(float x) { return __builtin_amdgcn_exp2f(x); }
__device__ __forceinline__ float fast_rcp(float x) { return __builtin_amdgcn_rcpf(x); }
__device__ __forceinline__ float uniform_f(float x) { return __uint_as_float((unsigned)__builtin_amdgcn_readfirstlane((int)__float_as_uint(x))); }
__device__ __forceinline__ f32x4 mfma16(bf16x8 a, bf16x8 b, f32x4 c) { return __builtin_amdgcn_mfma_f32_16x16x32_bf16(a, b, c, 0, 0, 0); }
template <class T> __device__ __forceinline__ T* uniform_ptr(T* p) {
    const unsigned long long v = (unsigned long long)p;
    const unsigned lo = (unsigned)__builtin_amdgcn_readfirstlane((int)(unsigned)v), hi = (unsigned)__builtin_amdgcn_readfirstlane((int)(unsigned)(v >> 32));
    return (T*)(((unsigned long long)hi << 32) | lo);
}
__device__ __forceinline__ int tile_row(int b, int j) { return j == 0 ? b * 16 : (RB - 16) + b * SEQ + 16 * j; }

namespace pg8 {
constexpr int BM = 256, BK = 64, HALF = 128, HTB = HALF * BK * 2, STAGE_BYTES = 8 * HTB, NXCD = 8, WGM = 4;
__device__ __forceinline__ int lds_byte(int r, int c) { const int st = (r >> 4) * 2 + (c >> 5), rr = r & 15, cc = c & 31, ob = rr * 64 + cc * 2; return st * 1024 + (ob ^ (((ob >> 9) & 1) << 5)); }
__device__ __forceinline__ void stage_rc(int b, int& R, int& C) { const int st = b / 1024, sb = b % 1024, swz = sb ^ (((sb >> 9) & 1) << 5); R = (st >> 1) * 16 + swz / 64; C = (st & 1) * 32 + (swz % 64) / 2; }
__device__ __forceinline__ int perm32(int rho) { const int n = rho >> 4, i = rho & 15; return 8 * (i >> 2) + 4 * n + (i & 3); }

struct GUnit { const char* A; const char* B; unsigned lda, ldb; int nt, kind, pm, pn; };

__device__ __forceinline__ void tile_map(int L, int nM, int nN, int& pm, int& pn) {
    const int nwg = nM * nN; int wgid = L;
    { const int q = nwg / NXCD, r = nwg % NXCD, xcd = wgid % NXCD, off = wgid / NXCD; wgid = (xcd < r ? xcd * (q + 1) : r * (q + 1) + (xcd - r) * q) + off; }
    const int nig = WGM * nN, gid = wgid / nig, fm = gid * WGM, gsz = (nM - fm) < WGM ? (nM - fm) : WGM;
    pm = fm + ((wgid % nig) % gsz); pn = (wgid % nig) / gsz;
}

template <class Epi, class Sched>
__device__ __forceinline__ void gemm_phase(LAS unsigned char* lds, const Sched& S, const Epi& E, const int tid) {
    const int wid = __builtin_amdgcn_readfirstlane(tid >> 6), lane = tid & 63, wr = wid >> 2, wc = wid & 3, fr = lane & 15, fq = lane >> 4;
    int sR[2], sC[2], sRbi[2];
#pragma unroll
    for (int i = 0; i < 2; ++i) { stage_rc(tid * 16 + i * 8192, sR[i], sC[i]); sRbi[i] = (sR[i] & ~31) + perm32(sR[i] & 31); }
    const unsigned ldsw = (unsigned)wid * 1024u;
    const int aoff = lds_byte(wr * 64 + fr, fq * 8), boff = lds_byte(wc * 32 + fr, fq * 8);
#define PG8_SA(b, h) (((b) * 2 + (h)) * HTB)
#define PG8_SB(b, h) ((4 + (b) * 2 + (h)) * HTB)
#define PG8_STAGE(bufoff, gbase, rows) do { _Pragma("unroll") for (int _i = 0; _i < 2; ++_i) \
        __builtin_amdgcn_global_load_lds((const unsigned*)((const char*)(gbase) + (rows)[_i]), (LAS unsigned*)(lds + (bufoff) + ldsw + _i * 8192), 16, 0, 0); } while (0)
#define PG8_LDA(dst, b, h) do { _Pragma("unroll") for (int m = 0; m < 4; ++m) _Pragma("unroll") for (int k = 0; k < 2; ++k) dst[m][k] = *(const LAS bf16x8*)(lds + PG8_SA(b, h) + aoff + m * 2048 + k * 1024); } while (0)
#define PG8_LDB(dst, b, h) do { _Pragma("unroll") for (int n = 0; n < 2; ++n) _Pragma("unroll") for (int k = 0; k < 2; ++k) dst[n][k] = *(const LAS bf16x8*)(lds + PG8_SB(b, h) + boff + n * 2048 + k * 1024); } while (0)
#define PG8_MMA(ai, bj, At, Bt) do { __builtin_amdgcn_s_setprio(1); _Pragma("unroll") for (int m = 0; m < 4; ++m) _Pragma("unroll") for (int n = 0; n < 2; ++n) _Pragma("unroll") for (int k = 0; k < 2; ++k) \
        acc[ai][bj][m][n] = __builtin_amdgcn_mfma_f32_16x16x32_bf16(Bt[n][k], At[m][k], acc[ai][bj][m][n], 0, 0, 0); __builtin_amdgcn_s_setprio(0); } while (0)
#define PG8_WAIT_V(n) asm volatile("s_waitcnt vmcnt(" #n ")" ::: "memory")
#define PG8_WAIT_L(n) asm volatile("s_waitcnt lgkmcnt(" #n ")" ::: "memory")
#define PG8_BAR __builtin_amdgcn_s_barrier()
#define PG8_SCHED __builtin_amdgcn_sched_barrier(0)
    GUnit cur, nxt; int ui = 0;
    if (!S.next(0, cur)) return;
    f32x4 acc[2][2][4][2];
#pragma unroll
    for (int a = 0; a < 2; ++a)
#pragma unroll
        for (int b = 0; b < 2; ++b)
#pragma unroll
            for (int m = 0; m < 4; ++m)
#pragma unroll
                for (int n = 0; n < 2; ++n) acc[a][b][m][n] = (f32x4){0.f, 0.f, 0.f, 0.f};
    bf16x8 At[4][2], B0[2][2], B1[2][2];
    const char* cA = cur.A; const char* cB = cur.B;
    constexpr unsigned kstep = (unsigned)(BK * 2);
    const unsigned lda = cur.lda, ldb = cur.ldb, hA = HALF * lda, hB = HALF * ldb;
    unsigned vA[2], vB[2];
#pragma unroll
    for (int i = 0; i < 2; ++i) { vA[i] = (unsigned)sR[i] * lda + (unsigned)sC[i] * 2u; vB[i] = (unsigned)sRbi[i] * ldb + (unsigned)sC[i] * 2u; }
    PG8_STAGE(PG8_SB(0, 0), cB, vB); PG8_STAGE(PG8_SB(0, 1), cB + hB, vB); PG8_STAGE(PG8_SA(0, 0), cA, vA); PG8_STAGE(PG8_SA(0, 1), cA + hA, vA);
    if (wr == 1) PG8_BAR;
    PG8_WAIT_V(2); PG8_BAR;
    PG8_STAGE(PG8_SB(1, 0), cB + kstep, vB); PG8_STAGE(PG8_SA(1, 0), cA + kstep, vA); PG8_STAGE(PG8_SB(1, 1), cB + hB + kstep, vB);
    PG8_WAIT_V(6); PG8_BAR;
    for (;;) {
        const bool has_next = S.next(ui + 1, nxt);
        const char* nA = has_next ? nxt.A : cA; const char* nB = has_next ? nxt.B : cB;
        const int nt = cur.nt;
        for (int t = 0; t < nt; t += 2) {
            const bool last = (t == nt - 2);
            const char* a1 = cA + (size_t)(t + 1) * kstep;
            const char* a2 = last ? nA : cA + (size_t)(t + 2) * kstep; const char* b2 = last ? nB : cB + (size_t)(t + 2) * kstep;
            const char* a3 = a2 + kstep; const char* b3 = b2 + kstep;
            PG8_LDB(B0, 0, 0); PG8_LDB(B1, 0, 1); PG8_SCHED; PG8_LDA(At, 0, 0); PG8_STAGE(PG8_SA(1, 1), a1 + hA, vA);
            PG8_WAIT_V(8); PG8_WAIT_L(0); PG8_BAR; PG8_MMA(0, 0, At, B0); PG8_MMA(0, 1, At, B1); PG8_BAR; PG8_SCHED;
            PG8_LDA(At, 0, 1); PG8_STAGE(PG8_SB(0, 0), b2, vB); PG8_STAGE(PG8_SB(0, 1), b2 + hB, vB); PG8_STAGE(PG8_SA(0, 0), a2, vA);
            PG8_WAIT_V(8); PG8_WAIT_L(0); PG8_BAR; PG8_MMA(1, 0, At, B0); PG8_MMA(1, 1, At, B1); PG8_BAR; PG8_SCHED;
            PG8_LDB(B0, 1, 0); PG8_LDB(B1, 1, 1); PG8_SCHED; PG8_LDA(At, 1, 0); PG8_STAGE(PG8_SA(0, 1), a2 + hA, vA);
            PG8_WAIT_V(8); PG8_WAIT_L(0); PG8_BAR; PG8_MMA(0, 0, At, B0); PG8_MMA(0, 1, At, B1); PG8_BAR; PG8_SCHED;
            PG8_LDA(At, 1, 1); PG8_STAGE(PG8_SB(1, 0), b3, vB); PG8_STAGE(PG8_SB(1, 1), b3 + hB, vB); PG8_STAGE(PG8_SA(1, 0), a3, vA);
            PG8_WAIT_V(8); PG8_WAIT_L(0); PG8_BAR; PG8_MMA(1, 0, At, B0); PG8_MMA(1, 1, At, B1); PG8_BAR; PG8_SCHED;
        }
        if (wr == 0) PG8_BAR;
        E(acc, cur);
        if (!has_next) break;
#pragma unroll
        for (int a = 0; a < 2; ++a)
#pragma unroll
            for (int b = 0; b < 2; ++b)
#pragma unroll
                for (int m = 0; m < 4; ++m)
#pragma unroll
                    for (int n = 0; n < 2; ++n) acc[a][b][m][n] = (f32x4){0.f, 0.f, 0.f, 0.f};
        cur = nxt; cA = nA; cB = nB; ++ui;
        if (wr == 1) PG8_BAR;
    }
    PG8_WAIT_V(0);
    PG8_BAR;
#undef PG8_SA
#undef PG8_SB
#undef PG8_STAGE
#undef PG8_LDA
#undef PG8_LDB
#undef PG8_MMA
#undef PG8_WAIT_V
#undef PG8_WAIT_L
#undef PG8_BAR
#undef PG8_SCHED
}
}
using pg8::GUnit;

struct SchedIn {
    const char* U; const char* WT; int G, c;
    __device__ __forceinline__ bool next(int i, GUnit& u) const {
        const int L = i * G + c; int pm, pn;
        if (L < 3096) { pg8::tile_map(L, 129, 24, pm, pn); u.A = U + (size_t)pm * 256 * 4096; u.B = WT + (size_t)pn * 256 * 4096; u.kind = 0; }
        else if (L < 3096 + 1548) { pg8::tile_map(L - 3096, 12, 129, pm, pn); u.A = WT + (size_t)(NPROJ + pm * 256) * 4096; u.B = U + (size_t)pn * 256 * 4096; u.kind = 1; }
        else if (L < 3096 + 1548 + 24) { const int idx = L - (3096 + 1548); pm = idx >> 3; pn = idx & 7;
            u.A = U; u.B = WT + (size_t)(9216 + pm * 2048 + pn * 256) * 4096; u.kind = 2; }
        else return false;
        u.pm = pm; u.pn = pn; u.lda = 4096; u.ldb = 4096; u.nt = 32; return true;
    }
};
struct SchedPlain {
    const char* A; const char* B; unsigned lda, ldb; int nt, nM, nN, pm0, G, c;
    __device__ __forceinline__ bool next(int i, GUnit& u) const {
        const int L = i * G + c; if (L >= nM * nN) return false;
        int pm, pn; pg8::tile_map(L, nM, nN, pm, pn); pm += pm0;
        u.pm = pm; u.pn = pn; u.kind = 0; u.A = A + (size_t)pm * 256 * lda; u.B = B + (size_t)pn * 256 * ldb; u.lda = lda; u.ldb = ldb; u.nt = nt; return true;
    }
};

struct LaneId { int wr, wc, fr, fq; };
__device__ __forceinline__ LaneId lane_id_fresh() { int t = threadIdx.x; asm volatile("" : "+v"(t)); LaneId r; r.wr = t >> 8; r.wc = (t >> 6) & 3; r.fr = t & 15; r.fq = (t >> 4) & 3; return r; }
__device__ __forceinline__ float sigmoid_f(float x) { return fast_rcp(1.0f + fast_exp2(-x * LOG2E)); }
struct EpiIn {
    bf16_t* PROJ; bf16_t* VT; bf16_t* GATEM;
    __device__ __forceinline__ void operator()(const f32x4 (&acc)[2][2][4][2], const GUnit& u) const {
        const LaneId L_ = lane_id_fresh(); const int wr = L_.wr, wc = L_.wc, fr = L_.fr, fq = L_.fq;
        char* base; unsigned ldb2;
        if (u.kind == 0) { base = (char*)(PROJ + (size_t)(u.pn >> 3) * PBUF + (size_t)u.pm * 256 * PP + (size_t)(u.pn & 7) * 256); ldb2 = PP * 2; }
        else if (u.kind == 1) { base = (char*)(VT + (size_t)u.pm * 256 * M + (size_t)u.pn * 256); ldb2 = M * 2; }
        else { base = (char*)(GATEM + (size_t)u.pm * 256 * D + (size_t)u.pn * 256); ldb2 = D * 2; }
        base = uniform_ptr(base);
        const unsigned lo = (unsigned)(wr * 64 + fr) * ldb2 + (unsigned)(wc * 32 + 8 * fq) * 2u;
        const bool sg = u.kind == 2;
#pragma unroll
        for (int ai = 0; ai < 2; ++ai)
#pragma unroll
            for (int m = 0; m < 4; ++m) { const unsigned ro = lo + (unsigned)(ai * 128 + m * 16) * ldb2;
#pragma unroll
                for (int bj = 0; bj < 2; ++bj) { f32x4 v0 = acc[ai][bj][m][0], v1 = acc[ai][bj][m][1];
                    if (sg) {
#pragma unroll
                        for (int j = 0; j < 4; ++j) { v0[j] = sigmoid_f(v0[j]); v1[j] = sigmoid_f(v1[j]); } }
                    u32x4 w; w.x = cvt_pk_bf16(v0[0], v0[1]); w.y = cvt_pk_bf16(v0[2], v0[3]); w.z = cvt_pk_bf16(v1[0], v1[1]); w.w = cvt_pk_bf16(v1[2], v1[3]);
                    *(u32x4*)(base + (ro + bj * 256u)) = w; } }
    }
};
struct EpiGate {
    bf16_t* GATE;
    __device__ __forceinline__ void operator()(const f32x4 (&acc)[2][2][4][2], const GUnit& u) const {
        const LaneId L_ = lane_id_fresh(); const int wr = L_.wr, wc = L_.wc, fr = L_.fr, fq = L_.fq;
        char* gb = uniform_ptr((char*)(GATE + (size_t)u.pm * 256 * D + (size_t)u.pn * 256));
        const unsigned lo = (unsigned)(wr * 64 + fr) * (D * 2u) + (unsigned)(wc * 32 + 8 * fq) * 2u;
#pragma unroll
        for (int ai = 0; ai < 2; ++ai)
#pragma unroll
            for (int m = 0; m < 4; ++m)
#pragma unroll
                for (int bj = 0; bj < 2; ++bj) { const f32x4 v0 = acc[ai][bj][m][0], v1 = acc[ai][bj][m][1];
                    u32x4 w; w.x = cvt_pk_bf16(sigmoid_f(v0[0]), sigmoid_f(v0[1])); w.y = cvt_pk_bf16(sigmoid_f(v0[2]), sigmoid_f(v0[3]));
                    w.z = cvt_pk_bf16(sigmoid_f(v1[0]), sigmoid_f(v1[1])); w.w = cvt_pk_bf16(sigmoid_f(v1[2]), sigmoid_f(v1[3]));
                    *(u32x4*)(gb + (lo + (unsigned)(ai * 128 + m * 16) * (D * 2u) + bj * 256u)) = w; }
    }
};
struct EpiYM {
    const bf16_t* GATE; bf16_t* MERGED; int first; const bf16_t* GATEM;
    __device__ __forceinline__ void operator()(const f32x4 (&acc)[2][2][4][2], const GUnit& u) const {
        const LaneId L_ = lane_id_fresh(); const int wr = L_.wr, wc = L_.wc, fr = L_.fr, fq = L_.fq;
        const size_t tb = (size_t)u.pm * 256 * D + (size_t)u.pn * 256;
        const char* gb = uniform_ptr((const char*)(u.pm == 0 ? GATEM + (size_t)u.pn * 256 : GATE + tb)); char* mgb = uniform_ptr((char*)(MERGED + tb));
        const unsigned lo = (unsigned)(wr * 64 + fr) * (D * 2u) + (unsigned)(wc * 32 + 8 * fq) * 2u;
#pragma unroll
        for (int ai = 0; ai < 2; ++ai) {
            u32x4 gq[4][2], pq[4][2];
#pragma unroll
            for (int m = 0; m < 4; ++m)
#pragma unroll
                for (int bj = 0; bj < 2; ++bj) { const unsigned o = lo + (unsigned)(ai * 128 + m * 16) * (D * 2u) + bj * 256u;
                    gq[m][bj] = *(const u32x4*)(gb + o); pq[m][bj] = first ? (u32x4){0u, 0u, 0u, 0u} : *(const u32x4*)(mgb + o); }
#pragma unroll
            for (int m = 0; m < 4; ++m)
#pragma unroll
                for (int bj = 0; bj < 2; ++bj) { const f32x4 v0 = acc[ai][bj][m][0], v1 = acc[ai][bj][m][1];
                    const unsigned o = lo + (unsigned)(ai * 128 + m * 16) * (D * 2u) + bj * 256u;
                    const u32x4 g = gq[m][bj], p = pq[m][bj];
                    float r[8];
                    r[0] = v0[0] * lo_f(g.x) + lo_f(p.x); r[1] = v0[1] * hi_f(g.x) + hi_f(p.x); r[2] = v0[2] * lo_f(g.y) + lo_f(p.y); r[3] = v0[3] * hi_f(g.y) + hi_f(p.y);
                    r[4] = v1[0] * lo_f(g.z) + lo_f(p.z); r[5] = v1[1] * hi_f(g.z) + hi_f(p.z); r[6] = v1[2] * lo_f(g.w) + lo_f(p.w); r[7] = v1[3] * hi_f(g.w) + hi_f(p.w);
                    u32x4 w; w.x = cvt_pk_bf16(r[0], r[1]); w.y = cvt_pk_bf16(r[2], r[3]); w.z = cvt_pk_bf16(r[4], r[5]); w.w = cvt_pk_bf16(r[6], r[7]);
                    *(u32x4*)(mgb + o) = w; }
            asm volatile("" ::: "memory");
        }
    }
};
struct EpiResid {
    const float* in_real; const float* in_meta; float* out_real; float* out_meta;
    __device__ __forceinline__ void operator()(const f32x4 (&acc)[2][2][4][2], const GUnit& u) const {
        const LaneId L_ = lane_id_fresh(); const int wr = L_.wr, wc = L_.wc, fr = L_.fr, fq = L_.fq;
        const char* ip; char* op;
        if (u.pm == 0) { ip = (const char*)(in_meta + u.pn * 256); op = (char*)(out_meta + u.pn * 256); }
        else { ip = (const char*)(in_real + (size_t)(u.pm - 1) * 256 * D + u.pn * 256); op = (char*)(out_real + (size_t)(u.pm - 1) * 256 * D + u.pn * 256); }
        ip = uniform_ptr(ip); op = uniform_ptr(op);
        const unsigned lo = (unsigned)(wr * 64 + fr) * (D * 4u) + (unsigned)(wc * 32 + 8 * fq) * 4u;
#pragma unroll
        for (int ai = 0; ai < 2; ++ai) {
            f32x4 ra[4][2], rb[4][2];
#pragma unroll
            for (int m = 0; m < 4; ++m)
#pragma unroll
                for (int bj = 0; bj < 2; ++bj) { const unsigned o = lo + (unsigned)(ai * 128 + m * 16) * (D * 4u) + bj * 512u; ra[m][bj] = *(const f32x4*)(ip + o); rb[m][bj] = *(const f32x4*)(ip + (o + 16u)); }
#pragma unroll
            for (int m = 0; m < 4; ++m)
#pragma unroll
                for (int bj = 0; bj < 2; ++bj) { const unsigned o = lo + (unsigned)(ai * 128 + m * 16) * (D * 4u) + bj * 512u;
                    *(f32x4*)(op + o) = ra[m][bj] + acc[ai][bj][m][0]; *(f32x4*)(op + (o + 16u)) = rb[m][bj] + acc[ai][bj][m][1]; }
            asm volatile("" ::: "memory");
        }
    }
};
struct EpiUp {
    bf16_t* Gb; bf16_t* Vb;
    __device__ __forceinline__ void operator()(const f32x4 (&acc)[2][2][4][2], const GUnit& u) const {
        const LaneId L_ = lane_id_fresh(); const int wr = L_.wr, wc = L_.wc, fr = L_.fr, fq = L_.fq;
        const size_t tb = (size_t)u.pm * 256 * DFF + (size_t)u.pn * 128;
        char* gb = uniform_ptr((char*)(Gb + tb)); char* vb = uniform_ptr((char*)(Vb + tb));
        const unsigned lo = (unsigned)(wr * 64 + fr) * (DFF * 2u) + (unsigned)(wc * 32 + 8 * fq) * 2u;
#pragma unroll
        for (int ai = 0; ai < 2; ++ai)
#pragma unroll
            for (int m = 0; m < 4; ++m)
#pragma unroll
                for (int bj = 0; bj < 2; ++bj) { const f32x4 v0 = acc[ai][bj][m][0], v1 = acc[ai][bj][m][1];
                    u32x4 w; w.x = cvt_pk_bf16(v0[0], v0[1]); w.y = cvt_pk_bf16(v0[2], v0[3]); w.z = cvt_pk_bf16(v1[0], v1[1]); w.w = cvt_pk_bf16(v1[2], v1[3]);
                    *(u32x4*)((bj == 0 ? gb : vb) + (lo + (unsigned)(ai * 128 + m * 16) * (DFF * 2u))) = w; }
    }
};

__device__ __forceinline__ void transpose_item(const float* W, int K, int N, bf16_t* WT, int pitch, int kb, int n0, int drow0, LAS float* scr, int lane) {
    const int k0 = 64 * kb;
#pragma unroll 8
    for (int i = 0; i < 32; ++i) { const int kk = 2 * i + (lane >> 5); scr[kk * 33 + (lane & 31)] = W[(size_t)(k0 + kk) * N + n0 + (lane & 31)]; }
    asm volatile("s_waitcnt lgkmcnt(0)" ::: "memory");
    const int c = lane & 7;
#pragma unroll
    for (int j = 0; j < 4; ++j) { const int n = (lane >> 3) + 8 * j; const LAS float* s = scr + (8 * c) * 33 + n;
        u32x4 o; o.x = pk2(s[0 * 33], s[1 * 33]); o.y = pk2(s[2 * 33], s[3 * 33]); o.z = pk2(s[4 * 33], s[5 * 33]); o.w = pk2(s[6 * 33], s[7 * 33]);
        *(u32x4*)(WT + (size_t)(drow0 + n) * pitch + k0 + 8 * c) = o; }
    asm volatile("s_waitcnt lgkmcnt(0)" ::: "memory");
}
__device__ __forceinline__ int remap_in(int n) {
    if (n < 1024) return n;
    if (n < 2048) return NPROJ + V_RET + (n - 1024);
    if (n < 3072) return C_RG + (n - 2048);
    if (n < 5120) return C_DQ + (n - 3072);
    if (n < 6144) return NPROJ + V_DIFF + (n - 5120);
    if (n < 8192) return C_NQ + (n - 6144);
    if (n < 9216) return NPROJ + V_NA + (n - 8192);
    return n;
}
__device__ __forceinline__ int remap_up(int n) { return n < DFF ? (n / 128) * 256 + (n % 128) : ((n - DFF) / 128) * 256 + 128 + ((n - DFF) % 128); }

constexpr int CW_I_DN = (DFF / 64) * (D / 32), CW_NITEMS = (D / 64) * (NIN / 32) + 3 * (1024 / 64) * (D / 32) + (D / 64) * (D / 32) + (D / 64) * (2 * DFF / 32) + CW_I_DN;
__device__ __forceinline__ void convert_weights(ParamsCP pp, int layer, LAS unsigned char* lds, int gw, int ngw, int wave, int lane, int it0 = 0, int it1 = CW_NITEMS) {
    LAS float* scr = (LAS float*)(lds + wave * 16384);
    unsigned char* wt = pp->ws + WS_WT;
    constexpr int I_IN = (D / 64) * (NIN / 32), I_BR = (1024 / 64) * (D / 32), I_OUT = (D / 64) * (D / 32), I_UP = (D / 64) * (2 * DFF / 32), I_DN = (DFF / 64) * (D / 32);
    constexpr int NITEMS = I_IN + 3 * I_BR + I_OUT + I_UP + I_DN;
    static_assert(NITEMS == CW_NITEMS && I_DN == CW_I_DN, "item counts");
    for (int it = it0 + gw; it < it1; it += ngw) {
        int r = it;
        if (r < I_IN) { const int nblk = NIN / 32, kb = r / nblk, n0 = 32 * (r % nblk);
            transpose_item(pp->in[3] + (size_t)layer * D * NIN, D, NIN, (bf16_t*)(wt + WT_IN), D, kb, n0, remap_in(n0), scr, lane); continue; }
        r -= I_IN;
        if (r < 3 * I_BR) { const int br = r / I_BR; r -= br * I_BR; const int nblk = D / 32, kb = r / nblk, n0 = 32 * (r % nblk);
            transpose_item(pp->in[14 + br] + (size_t)layer * 1024 * D, 1024, D, (bf16_t*)(wt + WT_BR) + (size_t)br * D * 2048, 2048, kb, n0, n0, scr, lane); continue; }
        r -= 3 * I_BR;
        if (r < I_OUT) { const int nblk = D / 32, kb = r / nblk, n0 = 32 * (r % nblk);
            transpose_item(pp->in[17] + (size_t)layer * D * D, D, D, (bf16_t*)(wt + WT_OUT), D, kb, n0, n0, scr, lane); continue; }
        r -= I_OUT;
        if (r < I_UP) { const int nblk = 2 * DFF / 32, kb = r / nblk, n0 = 32 * (r % nblk);
            transpose_item(pp->in[19] + (size_t)layer * D * 2 * DFF, D, 2 * DFF, (bf16_t*)(wt + WT_UP), D, kb, n0, remap_up(n0), scr, lane); continue; }
        r -= I_UP;
        { const int nblk = D / 32, kb = r / nblk, n0 = 32 * (r % nblk);
            transpose_item(pp->in[22] + (size_t)layer * DFF * D, DFF, D, (bf16_t*)(wt + WT_DOWN), DFF, kb, n0, n0, scr, lane); }
    }
}

__device__ __forceinline__ void norm_row(const float* hrow, const float* g, bf16_t* urow, int lane) {
    const f32x4* xr = (const f32x4*)hrow + lane; const f32x4* gr = (const f32x4*)g + lane;
    f32x4 v[8], gg[8]; float s = 0.f;
#pragma unroll
    for (int j = 0; j < 8; ++j) { v[j] = xr[64 * j]; gg[j] = gr[64 * j]; }
#pragma unroll
    for (int j = 0; j < 8; ++j) s += (v[j].x * v[j].x + v[j].y * v[j].y) + (v[j].z * v[j].z + v[j].w * v[j].w);
    const float rstd = rsqrtf(wave_sum(s) * (1.0f / D) + EPS);
    u32x2* o8 = (u32x2*)urow + lane;
#pragma unroll
    for (int j = 0; j < 8; ++j) { u32x2 w; w.x = pk2(v[j].x * rstd * gg[j].x, v[j].y * rstd * gg[j].y); w.y = pk2(v[j].z * rstd * gg[j].z, v[j].w * rstd * gg[j].w); o8[64 * j] = w; }
}
__device__ __forceinline__ void norm_phase(ParamsCP pp, const float* gain, bool layer0_input, int gw, int ngw, int lane, int m0 = 0, int m1 = M) {
    bf16_t* U = (bf16_t*)(pp->ws + WS_U); const float* hmeta = (const float*)(pp->ws + WS_HMETA);
    for (int m = m0 + gw; m < m1; m += ngw) {
        const float* hrow;
        if (m < RB) hrow = layer0_input ? pp->in[1] + (size_t)(m & 15) * D : hmeta + (size_t)m * D;
        else hrow = (layer0_input ? pp->in[0] : (const float*)pp->out) + (size_t)(m - RB) * D;
        norm_row(hrow, gain, U + (size_t)m * D, lane);
    }
}

__device__ __forceinline__ void setup_phase(ParamsCP pp, int gtid, int ngt, int gw, int lane) {
    float2* r64 = (float2*)(pp->ws + WS_ROPE64); float2* r128 = (float2*)(pp->ws + WS_ROPE128);
    for (int i = gtid; i < LTOK * 32; i += ngt) { const int pos = i >> 5, f = i & 31; const float inv = powf(10000.0f, -(float)(2 * f) / 64.0f); float s, c; sincosf((float)pos * inv, &s, &c); r64[i] = make_float2(c, s); }
    for (int i = gtid; i < LTOK * 64; i += ngt) { const int pos = i >> 6, f = i & 63; const float inv = powf(10000.0f, -(float)(2 * f) / 128.0f); float s, c; sincosf((float)pos * inv, &s, &c); r128[i] = make_float2(c, s); }
    float* hmeta = (float*)(pp->ws + WS_HMETA);
    for (int i = gtid; i < 256 * D; i += ngt) { const int m = i / D, cidx = i % D; hmeta[i] = pp->in[1][(size_t)(m & 15) * D + cidx]; }
    if (gw < 2) {
        const int l = gw; float* misc = (float*)(pp->ws + WS_MISC) + 16 * l;
        const float* lv = pp->in[9] + (size_t)l * 512;
        float d01 = lv[lane] * lv[128 + lane] + lv[64 + lane] * lv[192 + lane];
        float d23 = lv[256 + lane] * lv[384 + lane] + lv[320 + lane] * lv[448 + lane];
        d01 = wave_sum(d01); d23 = wave_sum(d23);
        const float lam_init = (l == 0) ? 0.2f : 0.35550907f;
        const float lam = expf(d01) - expf(d23) + lam_init;
        const float* qg = pp->in[7] + l * 128; const float* kg = pp->in[8] + l * 128;
        const float gq = wave_max(fmaxf(fabsf(qg[lane]), fabsf(qg[64 + lane]))), gk = wave_max(fmaxf(fabsf(kg[lane]), fabsf(kg[64 + lane])));
        const float dbound = 11.3137085f * gq * gk * 1.02f;
        const float nqg = wave_max(fabsf(pp->in[11][l * 64 + lane])), nkg = wave_max(fabsf(pp->in[12][l * 64 + lane]));
        float rm = 0.f; const float* rpb = pp->in[13] + (size_t)l * 7440;
        for (int i = lane; i < 7440; i += 64) rm = fmaxf(rm, fabsf(rpb[i]));
        rm = wave_max(rm);
        const float nbound = 8.0f * nqg * nkg * 1.02f + rm;
        if (lane == 0) { misc[0] = lam; misc[1] = dbound; misc[2] = nbound; misc[3] = lam_init; }
    }
}

__device__ __forceinline__ void prep_phase(ParamsCP pp, int layer, int gw, int ngw, int lane) {
    bf16_t* PROJ = (bf16_t*)(pp->ws + WS_BIG + BIG_PROJ);
    const float2* r64 = (const float2*)(pp->ws + WS_ROPE64); const float2* r128 = (const float2*)(pp->ws + WS_ROPE128);
    const float* dqg = pp->in[7] + layer * 128; const float* dkg = pp->in[8] + layer * 128;
    const float* nqg = pp->in[11] + layer * 64; const float* nkg = pp->in[12] + layer * 64;
    const int g4 = lane >> 4, l16 = lane & 15, g2 = lane >> 5, l32 = lane & 31;
    const float dq0 = dqg[2 * l32], dq1 = dqg[2 * l32 + 1], dq2 = dqg[64 + 2 * l32], dq3 = dqg[64 + 2 * l32 + 1];
    const float dk0 = dkg[2 * l32], dk1 = dkg[2 * l32 + 1], dk2 = dkg[64 + 2 * l32], dk3 = dkg[64 + 2 * l32 + 1];
    const f32x4 nq4 = *(const f32x4*)(nqg + 4 * l16), nk4 = *(const f32x4*)(nkg + 4 * l16);
    for (int m = gw; m < M; m += ngw) {
        const int pos = m < RB ? (m & 15) : 16 + ((m - RB) & (SEQ - 1));
        bf16_t* row = PROJ + (size_t)m * PP; bf16_t* rowD = row + PBUF; bf16_t* rowN = row + 2 * PBUF;
        const float2 c64a = r64[pos * 32 + 2 * l16], c64b = r64[pos * 32 + 2 * l16 + 1], c128a = r128[pos * 64 + 2 * l32], c128b = r128[pos * 64 + 2 * l32 + 1];
        unsigned r1[4], r2[4], d1[8], d2[8]; u32x2 nn[8];
#pragma unroll
        for (int ps = 0; ps < 4; ++ps) { const int grp = ps * 4 + g4; r1[ps] = *(const unsigned*)(row + grp * 64 + 2 * l16); r2[ps] = *(const unsigned*)(row + grp * 64 + 32 + 2 * l16); }
#pragma unroll
        for (int ps = 0; ps < 8; ++ps) { const int grp = ps * 2 + g2; d1[ps] = *(const unsigned*)(rowD + grp * 128 + 2 * l32); d2[ps] = *(const unsigned*)(rowD + grp * 128 + 64 + 2 * l32); }
#pragma unroll
        for (int ps = 0; ps < 8; ++ps) { const int grp = ps * 4 + g4; nn[ps] = *(const u32x2*)(rowN + grp * 64 + 4 * l16); }
#pragma unroll
        for (int ps = 0; ps < 4; ++ps) { const int grp = ps * 4 + g4; const float sc = grp >= 8 ? 0.125f : 1.0f;
            const float a0 = lo_f(r1[ps]), a1 = hi_f(r1[ps]), b0 = lo_f(r2[ps]), b1 = hi_f(r2[ps]);
            *(unsigned*)(row + grp * 64 + 2 * l16) = pk2((a0 * c64a.x - b0 * c64a.y) * sc, (a1 * c64b.x - b1 * c64b.y) * sc);
            *(unsigned*)(row + grp * 64 + 32 + 2 * l16) = pk2((a0 * c64a.y + b0 * c64a.x) * sc, (a1 * c64b.y + b1 * c64b.x) * sc); }
#pragma unroll
        for (int ps = 0; ps < 8; ++ps) { const int grp = ps * 2 + g2; const bool isk = grp >= 8;
            float a0 = lo_f(d1[ps]), a1 = hi_f(d1[ps]), b0 = lo_f(d2[ps]), b1 = hi_f(d2[ps]);
            float ss = (a0 * a0 + a1 * a1) + (b0 * b0 + b1 * b1);
#pragma unroll
            for (int o = 1; o < 32; o <<= 1) ss += __shfl_xor(ss, o);
            const float rstd = rsqrtf(ss * (1.0f / 128.0f) + EPS);
            a0 *= rstd * (isk ? dk0 : dq0); a1 *= rstd * (isk ? dk1 : dq1); b0 *= rstd * (isk ? dk2 : dq2); b1 *= rstd * (isk ? dk3 : dq3);
            *(unsigned*)(rowD + grp * 128 + 2 * l32) = pk2(a0 * c128a.x - b0 * c128a.y, a1 * c128b.x - b1 * c128b.y);
            *(unsigned*)(rowD + grp * 128 + 64 + 2 * l32) = pk2(a0 * c128a.y + b0 * c128a.x, a1 * c128b.y + b1 * c128b.x); }
#pragma unroll
        for (int ps = 0; ps < 8; ++ps) { const int grp = ps * 4 + g4; const f32x4 gn = grp >= 16 ? nk4 : nq4;
            const float a0 = lo_f(nn[ps].x), a1 = hi_f(nn[ps].x), a2 = lo_f(nn[ps].y), a3 = hi_f(nn[ps].y);
            float ss = (a0 * a0 + a1 * a1) + (a2 * a2 + a3 * a3);
#pragma unroll
            for (int o = 1; o < 16; o <<= 1) ss += __shfl_xor(ss, o);
            const float rstd = rsqrtf(ss * (1.0f / 64.0f) + EPS);
            u32x2 o2; o2.x = pk2(a0 * rstd * gn.x, a1 * rstd * gn.y); o2.y = pk2(a2 * rstd * gn.z, a3 * rstd * gn.w);
            *(u32x2*)(rowN + grp * 64 + 4 * l16) = o2; }
    }
}

__device__ __forceinline__ int act_prev_row(int m) { if (m < RB) return (m & 15) > 0 ? m - 1 : -1; const int s = (m - RB) & (SEQ - 1), b = (m - RB) >> 11; return s > 0 ? m - 1 : b * 16 + 15; }
__device__ __forceinline__ int act_next_row(int m) { if (m < RB) return (m & 15) < 15 ? m + 1 : RB + (m >> 4) * SEQ; const int s = (m - RB) & (SEQ - 1); return s < SEQ - 1 ? m + 1 : -1; }
__device__ __forceinline__ void act_phase(ParamsCP pp, int layer, int gtid, int ngt) {
    const bf16_t* Gb = (const bf16_t*)(pp->ws + WS_BIG + BIG_G); bf16_t* Vb = (bf16_t*)(pp->ws + WS_BIG + BIG_V);
    const float* cw = pp->in[20] + (size_t)layer * 3 * DFF; const float* cb = pp->in[21] + (size_t)layer * DFF;
    constexpr int NCH = DFF / 8, NRB = M / 8;
    for (int i = gtid; i < NRB * NCH; i += ngt) {
        const int rb = i / NCH, ch = i - rb * NCH, c0 = ch * 8, m0 = rb * 8;
        const int mp = act_prev_row(m0), mn = act_next_row(m0 + 7);
        const u32x4 z = (u32x4){0u, 0u, 0u, 0u};
        u32x4 g[10], v[8];
        g[0] = mp >= 0 ? *(const u32x4*)(Gb + (size_t)mp * DFF + c0) : z;
#pragma unroll
        for (int r = 0; r < 8; ++r) { g[r + 1] = *(const u32x4*)(Gb + (size_t)(m0 + r) * DFF + c0); v[r] = *(const u32x4*)(Vb + (size_t)(m0 + r) * DFF + c0); }
        g[9] = mn >= 0 ? *(const u32x4*)(Gb + (size_t)mn * DFF + c0) : z;
        float w0[8], w1[8], w2[8], bb[8];
#pragma unroll
        for (int j = 0; j < 8; ++j) { w0[j] = cw[c0 + j]; w1[j] = cw[DFF + c0 + j]; w2[j] = cw[2 * DFF + c0 + j]; bb[j] = cb[c0 + j]; }
#pragma unroll
        for (int r = 0; r < 8; ++r) {
            const unsigned gp[4] = {g[r].x, g[r].y, g[r].z, g[r].w}, gc[4] = {g[r + 1].x, g[r + 1].y, g[r + 1].z, g[r + 1].w}, gn[4] = {g[r + 2].x, g[r + 2].y, g[r + 2].z, g[r + 2].w}, vv[4] = {v[r].x, v[r].y, v[r].z, v[r].w};
            float o[8];
#pragma unroll
            for (int j = 0; j < 4; ++j) {
                const float a0 = lo_f(gp[j]) * w0[2 * j] + lo_f(gc[j]) * w1[2 * j] + lo_f(gn[j]) * w2[2 * j] + bb[2 * j];
                const float a1 = hi_f(gp[j]) * w0[2 * j + 1] + hi_f(gc[j]) * w1[2 * j + 1] + hi_f(gn[j]) * w2[2 * j + 1] + bb[2 * j + 1];
                o[2 * j] = a0 * sigmoid_f(a0) * lo_f(vv[j]); o[2 * j + 1] = a1 * sigmoid_f(a1) * hi_f(vv[j]);
            }
            u32x4 w; w.x = pk2(o[0], o[1]); w.y = pk2(o[2], o[3]); w.z = pk2(o[4], o[5]); w.w = pk2(o[6], o[7]);
            *(u32x4*)(Vb + (size_t)(m0 + r) * DFF + c0) = w;
        }
    }
}

template <int KS>
__device__ __forceinline__ void load_k(bf16x8 (&kf)[KS], const bf16_t* kp) {
#pragma unroll
    for (int ks = 0; ks < KS; ++ks) kf[ks] = *(const bf16x8*)(kp + 32 * ks);
}
template <int KS>
__device__ __forceinline__ f32x4 st_mma(const bf16x8 (&kf)[KS], const bf16x8 (&qf)[KS]) {
    f32x4 s = (f32x4){0.f, 0.f, 0.f, 0.f};
#pragma unroll
    for (int ks = 0; ks < KS; ++ks) s = mfma16(kf[ks], qf[ks], s);
    return s;
}
__device__ __forceinline__ bf16x8 pack_p(const float (&p0)[4], const float (&p1)[4]) {
    u32x4 w; w.x = pk2(p0[0], p0[1]); w.y = pk2(p0[2], p0[3]); w.z = pk2(p1[0], p1[1]); w.w = pk2(p1[2], p1[3]);
    return __builtin_bit_cast(bf16x8, w);
}
template <int NT>
__device__ __forceinline__ void pv_step(f32x4 (&acc)[NT], bf16x8 pf, const bf16_t* v0, const bf16_t* v1) {
    constexpr int GRP = NT < 8 ? NT : 8;
#pragma unroll
    for (int g0 = 0; g0 < NT; g0 += GRP) {
        u32x2 va[GRP], vb[GRP];
#pragma unroll
        for (int i = 0; i < GRP; ++i) { va[i] = *(const u32x2*)(v0 + (size_t)(g0 + i) * 16 * M); vb[i] = *(const u32x2*)(v1 + (size_t)(g0 + i) * 16 * M); }
#pragma unroll
        for (int i = 0; i < GRP; ++i) asm volatile("" : "+v"(va[i]), "+v"(vb[i]));
#pragma unroll
        for (int i = 0; i < GRP; ++i) { u32x4 w; w.x = va[i].x; w.y = va[i].y; w.z = vb[i].x; w.w = vb[i].y; acc[g0 + i] = mfma16(pf, __builtin_bit_cast(bf16x8, w), acc[g0 + i]); }
    }
}

constexpr int MX_KBYTES = 32 * 272, MX_VBYTES = 256 * 80, MX_BUF = MX_KBYTES + MX_VBYTES, MX_FLAG = 2 * MX_BUF;
constexpr size_t BIG_RO = BIG_VT + (size_t)NVT * M * 2;
static_assert(BIG_RO + (size_t)M * 1024 * 2 <= BIG_BYTES, "RO fits");
static_assert(MX_FLAG + 64 <= 131072, "mixer LDS fits");
template <int DK, int DV, bool DIFF>
__device__ __forceinline__ void wg_attn_task(ParamsCP pp, int layer, LAS unsigned char* lds, int b, int h, int qb, int tid) {
    constexpr int KS = DK / 32, NT = DV / 16, KP = DK * 2 + 16, VP = 80, KCH = DK / 8, NV = (DV * 4 + 511) / 512;
    const bf16_t* PROJ = (const bf16_t*)(pp->ws + WS_BIG + BIG_PROJ); const bf16_t* VT = (const bf16_t*)(pp->ws + WS_BIG + BIG_VT);
    const int lane = tid & 63, wave = __builtin_amdgcn_readfirstlane(tid >> 6), c16 = lane & 15, quad = lane >> 4;
    const size_t qcol = DIFF ? PBUF + h * 256 : (size_t)(C_RQ + h * 64);
    const size_t kcol = DIFF ? PBUF + 1024 + h * 256 : (size_t)(C_RK + h * 64);
    const int vrow0 = DIFF ? V_DIFF + h * 256 : V_RET + h * 128;
    const int jraw = qb * 8 + wave; const bool active = jraw < 129; const int jq = active ? jraw : 128;
    const int qrow0 = tile_row(b, jq);
    const bool kcopy = tid < 32 * KCH; const int krow = tid / KCH, kch = tid % KCH;
    float lam = 0.f, cb = 0.f; float lgf = 0.f, lgb = 0.f;
    if (DIFF) { const float* misc = (const float*)(pp->ws + WS_MISC) + 16 * layer; lam = misc[0]; cb = misc[1] * LOG2E; }
    else { lgf = log1pf(-exp2f(-pp->in[4][layer * 8 + h])) * LOG2E; lgb = log1pf(-exp2f(-pp->in[5][layer * 8 + h])) * LOG2E; }
    const float sc = 0.08838834764831845f * LOG2E;
    const int tq = 16 * jq + c16;
    f32x4 O[NT];
#pragma unroll
    for (int e0 = 0; e0 < NT; ++e0) O[e0] = (f32x4){0.f, 0.f, 0.f, 0.f};
#pragma unroll 1
    for (int half = 0; half < (DIFF ? 2 : 1); ++half) {
        bf16x8 qf[KS];
        { const bf16_t* qp = PROJ + (size_t)(qrow0 + c16) * PP + qcol + half * 128 + 8 * quad;
#pragma unroll
            for (int ks = 0; ks < KS; ++ks) qf[ks] = *(const bf16x8*)(qp + 32 * ks); }
        f32x4 acc[NT];
#pragma unroll
        for (int e0 = 0; e0 < NT; ++e0) acc[e0] = (f32x4){0.f, 0.f, 0.f, 0.f};
        float lsum = 0.f;
        const size_t kc = kcol + half * 128 + kch * 8;
        u32x4 kreg = (u32x4){0u, 0u, 0u, 0u}, vreg[NV];
#define MX_ISSUE(step) do { const int jt0_ = 2 * (step), jt1_ = jt0_ + 1 < 129 ? jt0_ + 1 : 128; const int kr0_ = tile_row(b, jt0_), kr1_ = tile_row(b, jt1_); \
            if (kcopy) kreg = *(const u32x4*)(PROJ + (size_t)(krow < 16 ? kr0_ + krow : kr1_ + krow - 16) * PP + kc); \
            _Pragma("unroll") for (int i_ = 0; i_ < NV; ++i_) { const int id_ = tid + 512 * i_, vr_ = id_ >> 2, vc_ = id_ & 3; \
                vreg[i_] = *(const u32x4*)(VT + (size_t)(vrow0 + vr_) * M + ((vc_ < 2 ? kr0_ : kr1_) + (vc_ & 1) * 8)); } } while (0)
#define MX_COMMIT(buf) do { LAS unsigned char* bb_ = lds + (buf) * MX_BUF; \
            if (kcopy) *(LAS u32x4*)(bb_ + krow * KP + kch * 16) = kreg; \
            _Pragma("unroll") for (int i_ = 0; i_ < NV; ++i_) { const int id_ = tid + 512 * i_, vr_ = id_ >> 2, vc_ = id_ & 3; \
                *(LAS u32x4*)(bb_ + MX_KBYTES + vr_ * VP + vc_ * 16) = vreg[i_]; } } while (0)
        __syncthreads();
        MX_ISSUE(0); MX_COMMIT(0);
        __syncthreads();
#pragma unroll 1
        for (int st = 0; st < 65; ++st) {
            const int buf = st & 1;
            if (st + 1 < 65) MX_ISSUE(st + 1);
            const LAS unsigned char* kb = lds + buf * MX_BUF; const LAS unsigned char* vb = kb + MX_KBYTES;
            bf16x8 k0[KS], k1[KS];
#pragma unroll
            for (int ks = 0; ks < KS; ++ks) { k0[ks] = *(const LAS bf16x8*)(kb + c16 * KP + (32 * ks + 8 * quad) * 2); k1[ks] = *(const LAS bf16x8*)(kb + (16 + c16) * KP + (32 * ks + 8 * quad) * 2); }
            const f32x4 s0 = st_mma<KS>(k0, qf), s1 = st_mma<KS>(k1, qf);
            const bool v1 = 2 * st + 1 < 129;
            float p0[4], p1[4];
#pragma unroll
            for (int r = 0; r < 4; ++r) {
                if (DIFF) { p0[r] = fast_exp2(s0[r] * sc - cb); p1[r] = v1 ? fast_exp2(s1[r] * sc - cb) : 0.f; lsum += p0[r] + p1[r]; }
                else { const int d0 = tq - (32 * st + 4 * quad + r), d1 = d0 - 16;
                    p0[r] = s0[r] * fast_exp2(d0 >= 0 ? (float)d0 * lgf : (float)(-d0) * lgb);
                    p1[r] = v1 ? s1[r] * fast_exp2(d1 >= 0 ? (float)d1 * lgf : (float)(-d1) * lgb) : 0.f; }
            }
            const bf16x8 pf = pack_p(p0, p1);
#pragma unroll
            for (int e0 = 0; e0 < NT; ++e0) {
                const u32x2 va = *(const LAS u32x2*)(vb + (e0 * 16 + c16) * VP + 8 * quad), vbb = *(const LAS u32x2*)(vb + (e0 * 16 + c16) * VP + 32 + 8 * quad);
                u32x4 w; w.x = va.x; w.y = va.y; w.z = vbb.x; w.w = vbb.y;
                acc[e0] = mfma16(pf, __builtin_bit_cast(bf16x8, w), acc[e0]);
            }
            if (st + 1 < 65) MX_COMMIT(buf ^ 1);
            __syncthreads();
        }
#undef MX_ISSUE
#undef MX_COMMIT
        if (DIFF) {
            lsum += __shfl_xor(lsum, 16); lsum += __shfl_xor(lsum, 32);
            float il[4];
#pragma unroll
            for (int r = 0; r < 4; ++r) il[r] = 1.0f / __shfl(lsum, 4 * quad + r);
            const float f = half == 0 ? 1.0f : -lam;
#pragma unroll
            for (int e0 = 0; e0 < NT; ++e0)
#pragma unroll
                for (int r = 0; r < 4; ++r) O[e0][r] += f * acc[e0][r] * il[r];
        } else {
#pragma unroll
            for (int e0 = 0; e0 < NT; ++e0) O[e0] = acc[e0];
        }
    }
    if (active) {
        bf16_t* yb = DIFF ? (bf16_t*)(pp->ws + WS_BIG + BIG_PROJ) + PBUF + (size_t)(qrow0 + 4 * quad) * PP + h * 256 + c16
                          : (bf16_t*)(pp->ws + WS_BIG + BIG_RO) + (size_t)(qrow0 + 4 * quad) * 1024 + h * 128 + c16;
        const int pitch = DIFF ? PP : 1024;
#pragma unroll
        for (int e0 = 0; e0 < NT; ++e0)
#pragma unroll
            for (int r = 0; r < 4; ++r) yb[(size_t)r * pitch + e0 * 16] = (bf16_t)f2bf(O[e0][r]);
    }
}
constexpr int DF_KP = 528, DF_KBYTES = 32 * DF_KP, DF_BUF = DF_KBYTES + MX_VBYTES;
static_assert(2 * DF_BUF <= MX_FLAG || 2 * DF_BUF + 64 <= 131072, "diff LDS");
constexpr int DF_FLAG = 2 * DF_BUF;
__device__ __forceinline__ void wg_diff_task(ParamsCP pp, int layer, LAS unsigned char* lds, int b, int h, int qb, int tid_in) {
    constexpr int VP = 80;
    int tid = tid_in; asm volatile("" : "+v"(tid));
    const bf16_t* PROJ = (const bf16_t*)(pp->ws + WS_BIG + BIG_PROJ); const bf16_t* VT = (const bf16_t*)(pp->ws + WS_BIG + BIG_VT);
    const int lane = tid & 63, wave = __builtin_amdgcn_readfirstlane(tid >> 6), c16 = lane & 15, quad = lane >> 4;
    const size_t qcol = PBUF + h * 256, kcol = PBUF + 1024 + h * 256;
    const int vrow0 = V_DIFF + h * 256;
    const int jraw = qb * 8 + wave; const bool active = jraw < 129; const int jq = active ? jraw : 128;
    const int qrow0 = tile_row(b, jq);
    const float* misc = (const float*)(pp->ws + WS_MISC) + 16 * layer;
    const float lam = uniform_f(misc[0]), cb = uniform_f(misc[1] * LOG2E), sc = 0.08838834764831845f * LOG2E;
    bf16x8 qf0[4], qf1[4];
    { const bf16_t* qp = PROJ + (size_t)(qrow0 + c16) * PP + qcol + 8 * quad;
#pragma unroll
        for (int ks = 0; ks < 4; ++ks) { qf0[ks] = *(const bf16x8*)(qp + 32 * ks); qf1[ks] = *(const bf16x8*)(qp + 128 + 32 * ks); } }
    f32x4 acc0[16], acc1[16];
#pragma unroll
    for (int e0 = 0; e0 < 16; ++e0) { acc0[e0] = (f32x4){0.f, 0.f, 0.f, 0.f}; acc1[e0] = (f32x4){0.f, 0.f, 0.f, 0.f}; }
    float ls0 = 0.f, ls1 = 0.f;
    u32x4 kreg[2], vreg[2];
#define DF_ISSUE(step) do { const int jt0_ = 2 * (step), jt1_ = jt0_ + 1 < 129 ? jt0_ + 1 : 128; const int kr0_ = tile_row(b, jt0_), kr1_ = tile_row(b, jt1_); \
        _Pragma("unroll") for (int i_ = 0; i_ < 2; ++i_) { const int id_ = tid + 512 * i_, kr_ = id_ >> 5, kc_ = id_ & 31, vr_ = id_ >> 2, vc_ = id_ & 3; \
            kreg[i_] = *(const u32x4*)(PROJ + (size_t)(kr_ < 16 ? kr0_ + kr_ : kr1_ + kr_ - 16) * PP + kcol + kc_ * 8); \
            vreg[i_] = *(const u32x4*)(VT + (size_t)(vrow0 + vr_) * M + ((vc_ < 2 ? kr0_ : kr1_) + (vc_ & 1) * 8)); } } while (0)
#define DF_COMMIT(buf) do { LAS unsigned char* bb_ = lds + (buf) * DF_BUF; \
        _Pragma("unroll") for (int i_ = 0; i_ < 2; ++i_) { const int id_ = tid + 512 * i_, kr_ = id_ >> 5, kc_ = id_ & 31, vr_ = id_ >> 2, vc_ = id_ & 3; \
            *(LAS u32x4*)(bb_ + kr_ * DF_KP + kc_ * 16) = kreg[i_]; *(LAS u32x4*)(bb_ + DF_KBYTES + vr_ * VP + vc_ * 16) = vreg[i_]; } } while (0)
    __syncthreads();
    DF_ISSUE(0); DF_COMMIT(0);
    __syncthreads();
#pragma unroll 1
    for (int st = 0; st < 65; ++st) {
        const int buf = st & 1;
        if (st + 1 < 65) DF_ISSUE(st + 1);
        const LAS unsigned char* kb = lds + buf * DF_BUF; const LAS unsigned char* vb = kb + DF_KBYTES;
        const bool v1 = 2 * st + 1 < 129;
        bf16x8 pf0, pf1;
        {   bf16x8 k0[4], k1[4];
#pragma unroll
            for (int ks = 0; ks < 4; ++ks) { k0[ks] = *(const LAS bf16x8*)(kb + c16 * DF_KP + (32 * ks + 8 * quad) * 2); k1[ks] = *(const LAS bf16x8*)(kb + (16 + c16) * DF_KP + (32 * ks + 8 * quad) * 2); }
            const f32x4 s0 = st_mma<4>(k0, qf0), s1 = st_mma<4>(k1, qf0);
            float p0[4], p1[4];
#pragma unroll
            for (int r = 0; r < 4; ++r) { p0[r] = fast_exp2(s0[r] * sc - cb); p1[r] = v1 ? fast_exp2(s1[r] * sc - cb) : 0.f; ls0 += p0[r] + p1[r]; }
            pf0 = pack_p(p0, p1); }
        {   bf16x8 k0[4], k1[4];
#pragma unroll
            for (int ks = 0; ks < 4; ++ks) { k0[ks] = *(const LAS bf16x8*)(kb + c16 * DF_KP + 256 + (32 * ks + 8 * quad) * 2); k1[ks] = *(const LAS bf16x8*)(kb + (16 + c16) * DF_KP + 256 + (32 * ks + 8 * quad) * 2); }
            const f32x4 s0 = st_mma<4>(k0, qf1), s1 = st_mma<4>(k1, qf1);
            float p0[4], p1[4];
#pragma unroll
            for (int r = 0; r < 4; ++r) { p0[r] = fast_exp2(s0[r] * sc - cb); p1[r] = v1 ? fast_exp2(s1[r] * sc - cb) : 0.f; ls1 += p0[r] + p1[r]; }
            pf1 = pack_p(p0, p1); }
#pragma unroll
        for (int e0 = 0; e0 < 16; ++e0) {
            const u32x2 va = *(const LAS u32x2*)(vb + (e0 * 16 + c16) * VP + 8 * quad), vbb = *(const LAS u32x2*)(vb + (e0 * 16 + c16) * VP + 32 + 8 * quad);
            u32x4 w; w.x = va.x; w.y = va.y; w.z = vbb.x; w.w = vbb.y; const bf16x8 vf = __builtin_bit_cast(bf16x8, w);
            acc0[e0] = mfma16(pf0, vf, acc0[e0]); acc1[e0] = mfma16(pf1, vf, acc1[e0]);
        }
        if (st + 1 < 65) DF_COMMIT(buf ^ 1);
        __syncthreads();
    }
#undef DF_ISSUE
#undef DF_COMMIT
    ls0 += __shfl_xor(ls0, 16); ls0 += __shfl_xor(ls0, 32); ls1 += __shfl_xor(ls1, 16); ls1 += __shfl_xor(ls1, 32);
    float i0[4], i1[4];
#pragma unroll
    for (int r = 0; r < 4; ++r) { i0[r] = fast_rcp(__shfl(ls0, 4 * quad + r)); i1[r] = lam * fast_rcp(__shfl(ls1, 4 * quad + r)); }
    if (active) {
        bf16_t* yb = (bf16_t*)(pp->ws + WS_BIG + BIG_PROJ) + PBUF + (size_t)(qrow0 + 4 * quad) * PP + h * 256 + c16;
#pragma unroll
        for (int e0 = 0; e0 < 16; ++e0)
#pragma unroll
            for (int r = 0; r < 4; ++r) yb[(size_t)r * PP + e0 * 16] = (bf16_t)f2bf(acc0[e0][r] * i0[r] - acc1[e0][r] * i1[r]);
    }
}
__device__ __forceinline__ void diff_post_phase(ParamsCP pp, int layer, int gw, int ngw, int lane) {
    bf16_t* PD = (bf16_t*)(pp->ws + WS_BIG + BIG_PROJ) + PBUF;
    const float* misc = (const float*)(pp->ws + WS_MISC) + 16 * layer;
    const float cl = 1.0f - misc[3];
    const float* og = pp->in[10] + layer * 256;
    const f32x4 g4 = *(const f32x4*)(og + 4 * lane);
    for (int m = gw; m < M; m += ngw) {
        u32x2 w[4];
#pragma unroll
        for (int h = 0; h < 4; ++h) w[h] = *(const u32x2*)(PD + (size_t)m * PP + h * 256 + 4 * lane);
#pragma unroll
        for (int h = 0; h < 4; ++h) {
            const float a0 = lo_f(w[h].x), a1 = hi_f(w[h].x), a2 = lo_f(w[h].y), a3 = hi_f(w[h].y);
            const float ss = wave_sum((a0 * a0 + a1 * a1) + (a2 * a2 + a3 * a3));
            const float rs = rsqrtf(ss * (1.0f / 256.0f) + EPS) * cl;
            u32x2 o2; o2.x = pk2(a0 * rs * g4.x, a1 * rs * g4.y); o2.y = pk2(a2 * rs * g4.z, a3 * rs * g4.w);
            *(u32x2*)(PD + (size_t)m * PP + h * 256 + 4 * lane) = o2;
        }
    }
}
__device__ __forceinline__ void wg_ret_task(ParamsCP pp, int layer, LAS unsigned char* lds, int b, int h, int qb, int tid_in) {
    constexpr int KP = 144, VP = 80;
    int tid = tid_in; asm volatile("" : "+v"(tid));
    const bf16_t* PROJ = (const bf16_t*)(pp->ws + WS_BIG + BIG_PROJ); const bf16_t* VT = (const bf16_t*)(pp->ws + WS_BIG + BIG_VT);
    const int lane = tid & 63, wave = __builtin_amdgcn_readfirstlane(tid >> 6), c16 = lane & 15, quad = lane >> 4;
    const size_t qcol = C_RQ + h * 64, kcol = C_RK + h * 64;
    const int vrow0 = V_RET + h * 128;
    const int jrA = qb * 16 + wave, jrB = jrA + 8; const bool actA = jrA < 129, actB = jrB < 129; const int jA = actA ? jrA : 128, jB = actB ? jrB : 128;
    const int qrowA = tile_row(b, jA), qrowB = tile_row(b, jB);
    const bool kcopy = tid < 256; const int krow = (tid & 255) >> 3, kch = tid & 7, vr = tid >> 2, vc = tid & 3;
    const float lgf = log1pf(-exp2f(-pp->in[4][layer * 8 + h])) * LOG2E, lgb = log1pf(-exp2f(-pp->in[5][layer * 8 + h])) * LOG2E;
    const int tqA = 16 * jA + c16, tqB = 16 * jB + c16;
    bf16x8 qA[2], qB[2];
    { const bf16_t* qp = PROJ + (size_t)(qrowA + c16) * PP + qcol + 8 * quad; qA[0] = *(const bf16x8*)qp; qA[1] = *(const bf16x8*)(qp + 32);
      const bf16_t* qp2 = PROJ + (size_t)(qrowB + c16) * PP + qcol + 8 * quad; qB[0] = *(const bf16x8*)qp2; qB[1] = *(const bf16x8*)(qp2 + 32); }
    f32x4 accA[8], accB[8];
#pragma unroll
    for (int e0 = 0; e0 < 8; ++e0) { accA[e0] = (f32x4){0.f, 0.f, 0.f, 0.f}; accB[e0] = (f32x4){0.f, 0.f, 0.f, 0.f}; }
    u32x4 kr0s = (u32x4){0u, 0u, 0u, 0u}, vr0s = kr0s, kr1s = kr0s, vr1s = kr0s;
#define RT_ISSUE(KR, VR, step) do { const int s_ = (step) < 65 ? (step) : 64; const int jt0_ = 2 * s_, jt1_ = jt0_ + 1 < 129 ? jt0_ + 1 : 128; const int a0_ = tile_row(b, jt0_), a1_ = tile_row(b, jt1_); \
        if (kcopy) KR = *(const u32x4*)(PROJ + (size_t)(krow < 16 ? a0_ + krow : a1_ + krow - 16) * PP + kcol + kch * 8); \
        VR = *(const u32x4*)(VT + (size_t)(vrow0 + vr) * M + ((vc < 2 ? a0_ : a1_) + (vc & 1) * 8)); } while (0)
#define RT_COMMIT(KR, VR, buf) do { LAS unsigned char* bb_ = lds + (buf) * MX_BUF; \
        if (kcopy) *(LAS u32x4*)(bb_ + krow * KP + kch * 16) = KR; *(LAS u32x4*)(bb_ + MX_KBYTES + vr * VP + vc * 16) = VR; } while (0)
#define RT_COMPUTE(st, buf) do { const LAS unsigned char* kb = lds + (buf) * MX_BUF; const LAS unsigned char* vb = kb + MX_KBYTES; \
        bf16x8 k0[2], k1[2]; \
        _Pragma("unroll") for (int ks = 0; ks < 2; ++ks) { k0[ks] = *(const LAS bf16x8*)(kb + c16 * KP + (32 * ks + 8 * quad) * 2); k1[ks] = *(const LAS bf16x8*)(kb + (16 + c16) * KP + (32 * ks + 8 * quad) * 2); } \
        const f32x4 sA0 = st_mma<2>(k0, qA), sA1 = st_mma<2>(k1, qA), sB0 = st_mma<2>(k0, qB), sB1 = st_mma<2>(k1, qB); \
        const bool v1 = 2 * (st) + 1 < 129; float pa0[4], pa1[4], pb0[4], pb1[4]; \
        _Pragma("unroll") for (int r = 0; r < 4; ++r) { const int tk = 32 * (st) + 4 * quad + r; \
            const int dA0 = tqA - tk, dA1 = dA0 - 16, dB0 = tqB - tk, dB1 = dB0 - 16; \
            pa0[r] = sA0[r] * fast_exp2(dA0 >= 0 ? (float)dA0 * lgf : (float)(-dA0) * lgb); \
            pa1[r] = v1 ? sA1[r] * fast_exp2(dA1 >= 0 ? (float)dA1 * lgf : (float)(-dA1) * lgb) : 0.f; \
            pb0[r] = sB0[r] * fast_exp2(dB0 >= 0 ? (float)dB0 * lgf : (float)(-dB0) * lgb); \
            pb1[r] = v1 ? sB1[r] * fast_exp2(dB1 >= 0 ? (float)dB1 * lgf : (float)(-dB1) * lgb) : 0.f; } \
        const bf16x8 pfA = pack_p(pa0, pa1), pfB = pack_p(pb0, pb1); \
        _Pragma("unroll") for (int e0 = 0; e0 < 8; ++e0) { \
            const u32x2 va = *(const LAS u32x2*)(vb + (e0 * 16 + c16) * VP + 8 * quad), vbb = *(const LAS u32x2*)(vb + (e0 * 16 + c16) * VP + 32 + 8 * quad); \
            u32x4 w; w.x = va.x; w.y = va.y; w.z = vbb.x; w.w = vbb.y; const bf16x8 vf = __builtin_bit_cast(bf16x8, w); \
            accA[e0] = mfma16(pfA, vf, accA[e0]); accB[e0] = mfma16(pfB, vf, accB[e0]); } } while (0)
    __syncthreads();
    RT_ISSUE(kr0s, vr0s, 0); RT_COMMIT(kr0s, vr0s, 0); RT_ISSUE(kr1s, vr1s, 1);
    __syncthreads();
#pragma unroll 1
    for (int st = 0; st < 65; st += 2) {
        RT_ISSUE(kr0s, vr0s, st + 2); RT_COMPUTE(st, 0); RT_COMMIT(kr1s, vr1s, 1); __syncthreads();
        if (st + 1 < 65) { RT_ISSUE(kr1s, vr1s, st + 3); RT_COMPUTE(st + 1, 1); RT_COMMIT(kr0s, vr0s, 0); __syncthreads(); }
    }
#undef RT_ISSUE
#undef RT_COMMIT
#undef RT_COMPUTE
    bf16_t* ro = (bf16_t*)(pp->ws + WS_BIG + BIG_RO);
    if (actA) { bf16_t* yb = ro + (size_t)(qrowA + 4 * quad) * 1024 + h * 128 + c16;
#pragma unroll
        for (int e0 = 0; e0 < 8; ++e0)
#pragma unroll
            for (int r = 0; r < 4; ++r) yb[(size_t)r * 1024 + e0 * 16] = (bf16_t)f2bf(accA[e0][r]); }
    if (actB) { bf16_t* yb = ro + (size_t)(qrowB + 4 * quad) * 1024 + h * 128 + c16;
#pragma unroll
        for (int e0 = 0; e0 < 8; ++e0)
#pragma unroll
            for (int r = 0; r < 4; ++r) yb[(size_t)r * 1024 + e0 * 16] = (bf16_t)f2bf(accB[e0][r]); }
}
__device__ __forceinline__ void ret_post_phase(ParamsCP pp, int layer, int gw, int ngw, int lane) {
    bf16_t* PR = (bf16_t*)(pp->ws + WS_BIG + BIG_PROJ); const bf16_t* RO = (const bf16_t*)(pp->ws + WS_BIG + BIG_RO);
    const float* og = pp->in[6] + layer * 1024;
    float o0[8], o1[8];
#pragma unroll
    for (int h = 0; h < 8; ++h) { o0[h] = og[h * 128 + 2 * lane]; o1[h] = og[h * 128 + 2 * lane + 1]; }
    for (int m = gw; m < M; m += ngw) {
        unsigned w[8], gv[8];
#pragma unroll
        for (int h = 0; h < 8; ++h) { w[h] = *(const unsigned*)(RO + (size_t)m * 1024 + h * 128 + 2 * lane); gv[h] = *(const unsigned*)(PR + (size_t)m * PP + C_RG + h * 128 + 2 * lane); }
#pragma unroll
        for (int h = 0; h < 8; ++h) {
            const float a0 = lo_f(w[h]), a1 = hi_f(w[h]), g0 = lo_f(gv[h]), g1 = hi_f(gv[h]);
            const float ss = wave_sum(a0 * a0 + a1 * a1);
            const float rs = rsqrtf(ss * (1.0f / 128.0f) + EPS);
            *(unsigned*)(PR + (size_t)m * PP + C_RG + h * 128 + 2 * lane) = pk2(a0 * rs * o0[h] * g0 * sigmoid_f(g0), a1 * rs * o1[h] * g1 * sigmoid_f(g1));
        }
    }
}

__device__ __forceinline__ void na_task(ParamsCP pp, int layer, int b, int h, int r, int g, int lane_in) {
    int lane = lane_in; asm volatile("" : "+v"(lane));
    const bf16_t* PROJ = (const bf16_t*)(pp->ws + WS_BIG + BIG_PROJ); const bf16_t* VT = (const bf16_t*)(pp->ws + WS_BIG + BIG_VT);
    const float* misc = (const float*)(pp->ws + WS_MISC) + 16 * layer;
    const float bound = misc[2];
    const float* rpb = pp->in[13] + (size_t)layer * 7440 + (size_t)h * 465;
    const int c16 = lane & 15, quad = lane >> 4;
    const bool meta = r < 0;
    const int qrow0 = meta ? b * 16 : RB + b * SEQ + r * 64 + 16 * g;
    bf16x8 qf[2];
    { const bf16_t* qp = PROJ + 2 * PBUF + (size_t)(qrow0 + c16) * PP + h * 64 + 8 * quad; qf[0] = *(const bf16x8*)qp; qf[1] = *(const bf16x8*)(qp + 32); }
    f32x4 acc[4];
#pragma unroll
    for (int e0 = 0; e0 < 4; ++e0) acc[e0] = (f32x4){0.f, 0.f, 0.f, 0.f};
    float lsum = 0.f;
    const size_t colk = 2 * PBUF + 1024 + h * 64 + 8 * quad;
    const bf16_t* vbase = VT + (size_t)(V_NA + h * 64 + c16) * M + 4 * quad;
    const int qc = 16 * g + c16;
    int cstart = qc - 8; cstart = cstart < 0 ? 0 : (cstart > 48 ? 48 : cstart);
    int rs = r - 4; rs = rs < 0 ? 0 : (rs > 24 ? 24 : rs);
    int cw0 = 16 * g - 8; cw0 = cw0 < 0 ? 0 : (cw0 > 32 ? 32 : cw0);
    int bi0[4], bi1[4]; bool ok0[4], ok1[4];
#pragma unroll
    for (int rr = 0; rr < 4; ++rr) { const int kc0 = cw0 + 4 * quad + rr, kc1 = kc0 + 16;
        int i0 = kc0 - qc + 15; i0 = i0 < 0 ? 0 : (i0 > 30 ? 30 : i0); int i1 = kc1 - qc + 15; i1 = i1 < 0 ? 0 : (i1 > 30 ? 30 : i1);
        bi0[rr] = i0; bi1[rr] = i1; ok0[rr] = kc0 >= cstart && kc0 < cstart + 16; ok1[rr] = kc1 >= cstart && kc1 < cstart + 16; }
    bf16x8 ck0[2], ck1[2], nk0[2], nk1[2]; u32x2 cva[4], cvb[4], nva[4], nvb[4]; float cb0[4], cb1[4], nb0[4], nb1[4];
#define NA_LOAD(K0, K1, VA, VB, B0, B1, s_) do { const bool win_ = (s_) < 8; const int kr0_ = win_ ? RB + b * SEQ + (rs + (s_)) * 64 + cw0 : b * 16; const int kr1_ = win_ ? kr0_ + 16 : kr0_; \
        load_k<2>(K0, PROJ + (size_t)(kr0_ + c16) * PP + colk); load_k<2>(K1, PROJ + (size_t)(kr1_ + c16) * PP + colk); \
        _Pragma("unroll") for (int e_ = 0; e_ < 4; ++e_) { VA[e_] = *(const u32x2*)(vbase + kr0_ + (size_t)e_ * 16 * M); VB[e_] = *(const u32x2*)(vbase + kr1_ + (size_t)e_ * 16 * M); } \
        const float* brow_ = rpb + (win_ ? (rs + (s_) - r + 7) * 31 : 0); \
        _Pragma("unroll") for (int rr_ = 0; rr_ < 4; ++rr_) { B0[rr_] = brow_[bi0[rr_]]; B1[rr_] = brow_[bi1[rr_]]; } } while (0)
    const int sfirst = meta ? 8 : 0;
    NA_LOAD(ck0, ck1, cva, cvb, cb0, cb1, sfirst);
#pragma unroll 1
    for (int s = sfirst; s < 9; ++s) {
        const bool win = s < 8;
        if (s + 1 < 9) NA_LOAD(nk0, nk1, nva, nvb, nb0, nb1, s + 1);
        asm volatile("" ::: "memory");
        const f32x4 s0 = st_mma<2>(ck0, qf), s1 = st_mma<2>(ck1, qf);
        float p0[4], p1[4];
#pragma unroll
        for (int rr = 0; rr < 4; ++rr) {
            if (win) { p0[rr] = ok0[rr] ? fast_exp2((s0[rr] * 0.125f + cb0[rr] - bound) * LOG2E) : 0.f; p1[rr] = ok1[rr] ? fast_exp2((s1[rr] * 0.125f + cb1[rr] - bound) * LOG2E) : 0.f; }
            else { p0[rr] = fast_exp2((s0[rr] * 0.125f - bound) * LOG2E); p1[rr] = 0.f; }
            lsum += p0[rr] + p1[rr];
        }
        const bf16x8 pf = pack_p(p0, p1);
#pragma unroll
        for (int e0 = 0; e0 < 4; ++e0) { u32x4 w; w.x = cva[e0].x; w.y = cva[e0].y; w.z = cvb[e0].x; w.w = cvb[e0].y; acc[e0] = mfma16(pf, __builtin_bit_cast(bf16x8, w), acc[e0]); }
#pragma unroll
        for (int i = 0; i < 2; ++i) { ck0[i] = nk0[i]; ck1[i] = nk1[i]; }
#pragma unroll
        for (int i = 0; i < 4; ++i) { cva[i] = nva[i]; cvb[i] = nvb[i]; cb0[i] = nb0[i]; cb1[i] = nb1[i]; }
    }
#undef NA_LOAD
    lsum += __shfl_xor(lsum, 16); lsum += __shfl_xor(lsum, 32);
    float il[4];
#pragma unroll
    for (int rr = 0; rr < 4; ++rr) il[rr] = 1.0f / __shfl(lsum, 4 * quad + rr);
    bf16_t* yb = (bf16_t*)(pp->ws + WS_BIG + BIG_PROJ) + 2 * PBUF + (size_t)(qrow0 + 4 * quad) * PP + h * 64 + c16;
#pragma unroll
    for (int e0 = 0; e0 < 4; ++e0)
#pragma unroll
        for (int rr = 0; rr < 4; ++rr) yb[(size_t)rr * PP + e0 * 16] = (bf16_t)f2bf(acc[e0][rr] * il[rr]);
}

constexpr int TW_DIFF = NBATCH * 4 * 17, TW_RET = NBATCH * 8 * 9, TW_TOTAL = TW_DIFF + TW_RET;
constexpr int T_NA = NBATCH * 16 * 128, T_NAM = NBATCH * 16, T_NATOTAL = T_NA + T_NAM;
__device__ __forceinline__ void mixer_phase(ParamsCP pp, int layer, LAS unsigned char* lds, int tid) {
    unsigned* ctrw = (unsigned*)(pp->ws + WS_CTL) + 64 * layer; unsigned* ctrn = ctrw + 128;
    const int lane = tid & 63;
    LAS unsigned* flag = (LAS unsigned*)(lds + DF_FLAG);
    for (;;) {
        __syncthreads();
        if (tid == 0) *flag = atomicAdd(ctrw, 1u);
        __syncthreads();
        const int q = (int)__builtin_amdgcn_readfirstlane((int)*flag);
        if (q >= TW_TOTAL) break;
        if (q < TW_DIFF) { const int b = q / 68, rem = q - b * 68, h = rem / 17, qb = rem - h * 17; wg_diff_task(pp, layer, lds, b, h, qb, tid); }
        else { const int q2 = q - TW_DIFF; const int b = q2 / 72, rem = q2 - b * 72, h = rem / 9, qb = rem - h * 9; wg_ret_task(pp, layer, lds, b, h, qb, tid); }
    }
    for (;;) {
        unsigned t = 0;
        if (lane == 0) t = atomicAdd(ctrn, 1u);
        t = (unsigned)__builtin_amdgcn_readfirstlane((int)t);
        if (t >= (unsigned)T_NATOTAL) break;
        int q = (int)t;
        if (q < T_NA) { const int b = q >> 11, rem = q & 2047, h = rem >> 7, rg = rem & 127; na_task(pp, layer, b, h, rg >> 2, rg & 3, lane); continue; }
        q -= T_NA;
        na_task(pp, layer, q >> 4, q & 15, -1, 0, lane);
    }
}

#define XB_TMO      128
#define XB_XCNT(j)  (256  + 64 * (j))
#define XB_XSUB(j)  (1280 + 64 * (j))
#define XB_XGEN(j)  (2304 + 64 * (j))
#define XB_TOP      3328
#define XB_TOPGEN   3392
#define XCD_BAR_WORDS 3456
#define XB_SPIN_CAP (1u << 18)
constexpr int CW_BAR = 1024;
static_assert((CW_BAR + XCD_BAR_WORDS) * 4 <= (int)CTL_BYTES, "barrier words inside the memset region");
__device__ __forceinline__ unsigned xb_ld(unsigned* p)              { return __hip_atomic_load(p, __ATOMIC_RELAXED, __HIP_MEMORY_SCOPE_AGENT); }
__device__ __forceinline__ unsigned xb_add(unsigned* p, unsigned v) { return __hip_atomic_fetch_add(p, v, __ATOMIC_RELAXED, __HIP_MEMORY_SCOPE_AGENT); }
__device__ __forceinline__ unsigned xb_xcc_id() { return (unsigned)__builtin_amdgcn_s_getreg((3 << 11) | 20) & 0xFu; }
#define XB_SPIN(cond, bar) do { unsigned _sp = 0; while (cond) { __builtin_amdgcn_s_sleep(1); \
    if ((++_sp & 255u) == 0u) { if (xb_ld(&(bar)[XB_TMO])) break; if (_sp > XB_SPIN_CAP) { atomicAdd(&(bar)[XB_TMO], 1u); break; } } } } while (0)
struct XcdBarrier { unsigned* bar; unsigned x; volatile LAS unsigned* st; };
__device__ __forceinline__ XcdBarrier xcd_barrier_post(unsigned* bar, volatile LAS unsigned* st) {
    XcdBarrier b; b.bar = bar; b.x = xb_xcc_id(); b.st = st;
    if (threadIdx.x == 0) (void)xb_add(&bar[XB_XCNT(b.x)], 1u);
    return b;
}
__device__ __forceinline__ void xcd_barrier_complete(unsigned* bar, unsigned x, unsigned& nloc, unsigned& nx) {
    const unsigned G = gridDim.x * gridDim.y * gridDim.z;
    unsigned sum, cnt, mine, sp = 0u;
    for (;;) {
        sum = 0u; cnt = 0u; mine = 0u;
#pragma unroll
        for (unsigned j = 0; j < 16; ++j) { const unsigned c = xb_ld(&bar[XB_XCNT(j)]); sum += c; cnt += (c > 0u) ? 1u : 0u; mine = (j == x) ? c : mine; }
        if (sum == G) break;
        __builtin_amdgcn_s_sleep(1);
        if ((++sp & 255u) == 0u) { if (xb_ld(&bar[XB_TMO])) break; if (sp > XB_SPIN_CAP) { atomicAdd(&bar[XB_TMO], 1u); break; } }
    }
    nloc = mine > 0u ? mine : 1u; nx = cnt > 0u ? cnt : 1u;
}
__device__ __forceinline__ void xcd_barrier(const XcdBarrier& b) {
    asm volatile("s_waitcnt vmcnt(0)" ::: "memory");
    __syncthreads();
    if (threadIdx.x == 0) {
        unsigned* bar = b.bar;
        __builtin_amdgcn_s_waitcnt(0);
        unsigned nloc = b.st[0], nx = b.st[1];
        if (nloc == 0u) { xcd_barrier_complete(bar, b.x, nloc, nx); b.st[0] = nloc; b.st[1] = nx; }
        const unsigned old = xb_add(&bar[XB_XSUB(b.x)], 1u);
        const unsigned gen = old / nloc;
        if (old + 1u == (gen + 1u) * nloc) {
            __builtin_amdgcn_fence(__ATOMIC_RELEASE, "agent");
            asm volatile("s_waitcnt vmcnt(0)" ::: "memory");
            const unsigned og = xb_add(&bar[XB_TOP], 1u);
            const unsigned tg = og / nx;
            if (og + 1u == (tg + 1u) * nx) xb_add(&bar[XB_TOPGEN], 1u);
            else XB_SPIN(xb_ld(&bar[XB_TOPGEN]) == tg, bar);
            __builtin_amdgcn_fence(__ATOMIC_ACQUIRE, "agent");
            xb_add(&bar[XB_XGEN(b.x)], 1u);
            asm volatile("s_waitcnt vmcnt(0)" ::: "memory");
        } else {
            XB_SPIN(xb_ld(&bar[XB_XGEN(b.x)]) == gen, bar);
            __builtin_amdgcn_fence(__ATOMIC_ACQUIRE, "agent");
            asm volatile("s_waitcnt vmcnt(0)" ::: "memory");
        }
    }
    __syncthreads();
}
__global__ void __launch_bounds__(512) fwd_kernel(Params p_unused) {
    extern __shared__ __attribute__((aligned(16))) unsigned char lds_raw[];
    LAS unsigned char* lds = (LAS unsigned char*)lds_raw;
    cg::grid_group grid = cg::this_grid();
    const int G = gridDim.x, blk = blockIdx.x;
    const int ngw = G * 8, ngt = G * 512;
    {
        volatile LAS unsigned* xst = (volatile LAS unsigned*)(lds + 131072 + 64);
        if (threadIdx.x == 0) { xst[0] = 0u; xst[1] = 0u; }
        __syncthreads();
        (void)xcd_barrier_post((unsigned*)(get_params()->ws + WS_CTL) + CW_BAR, xst);
        grid.sync();
    }
#define GRID_SYNC() do { asm volatile("s_waitcnt vmcnt(0) lgkmcnt(0)" ::: "memory"); { XcdBarrier xb_; xb_.bar = (unsigned*)(get_params()->ws + WS_CTL) + CW_BAR; xb_.x = xb_xcc_id(); xb_.st = (volatile LAS unsigned*)(lds + 131072 + 64); xcd_barrier(xb_); } asm volatile("" ::: "memory"); } while (0)
#define FRESH_IDS() int tid = threadIdx.x; asm volatile("" : "+v"(tid)); const int lane = tid & 63, wave = __builtin_amdgcn_readfirstlane(tid >> 6), gw = blk * 8 + wave, gtid = blk * 512 + tid; (void)lane; (void)gw; (void)gtid

    { unsigned* ctl0 = (unsigned*)(get_params()->ws + WS_CTL);
      if (blk == 0 && threadIdx.x < 4) __hip_atomic_store(ctl0 + 64 * threadIdx.x, 0u, __ATOMIC_RELAXED, __HIP_MEMORY_SCOPE_AGENT); }
#pragma unroll 1
    for (int layer = 0; layer < 2; ++layer) {
        { FRESH_IDS(); ParamsCP pp = get_params(); convert_weights(pp, layer, lds, gw, ngw, wave, lane, layer == 0 ? 0 : CW_NITEMS - CW_I_DN, CW_NITEMS); }
        if (layer == 0) { FRESH_IDS(); ParamsCP pp = get_params(); setup_phase(pp, gtid, ngt, gw, lane); }
        { FRESH_IDS(); ParamsCP pp = get_params(); norm_phase(pp, pp->in[2] + layer * D, layer == 0, gw, ngw, lane); }
        GRID_SYNC();
        { FRESH_IDS(); ParamsCP pp = get_params(); unsigned char* ws = pp->ws;
          SchedIn S{(const char*)(ws + WS_U), (const char*)(ws + WS_WT + WT_IN), G, blk}; EpiIn E{(bf16_t*)(ws + WS_BIG + BIG_PROJ), (bf16_t*)(ws + WS_BIG + BIG_VT), (bf16_t*)(ws + WS_GATEM)}; pg8::gemm_phase(lds, S, E, tid); }
        GRID_SYNC();
        { FRESH_IDS(); ParamsCP pp = get_params(); prep_phase(pp, layer, gw, ngw, lane); }
        GRID_SYNC();
        { FRESH_IDS(); ParamsCP pp = get_params(); mixer_phase(pp, layer, lds, tid); }
        GRID_SYNC();
        { FRESH_IDS(); ParamsCP pp = get_params(); diff_post_phase(pp, layer, gw, ngw, lane); ret_post_phase(pp, layer, gw, ngw, lane); }
        GRID_SYNC();
#pragma unroll 1
        for (int br = 0; br < 3; ++br) {
            { FRESH_IDS(); ParamsCP pp = get_params(); unsigned char* ws = pp->ws;
              SchedPlain S{(const char*)(ws + WS_U), (const char*)(ws + WS_WT + WT_IN + (size_t)(9216 + br * 2048) * 4096), 4096u, 4096u, 32, 128, 8, 1, G, blk};
              EpiGate E{(bf16_t*)(ws + WS_BIG + BIG_GATE)}; pg8::gemm_phase(lds, S, E, tid); }
            GRID_SYNC();
            { FRESH_IDS(); ParamsCP pp = get_params(); unsigned char* ws = pp->ws;
              const size_t yoff = ((size_t)br * PBUF + (br == 0 ? 1024 : 0)) * 2;
              SchedPlain S{(const char*)(ws + WS_BIG + BIG_PROJ + yoff), (const char*)(ws + WS_WT + WT_BR + (size_t)br * 2048 * 4096), 4096u, 4096u, 16, 129, 8, 0, G, blk};
              EpiYM E{(const bf16_t*)(ws + WS_BIG + BIG_GATE), (bf16_t*)(ws + WS_BIG + BIG_MERGED), br == 0 ? 1 : 0, (const bf16_t*)(ws + WS_GATEM) + (size_t)br * 256 * D}; pg8::gemm_phase(lds, S, E, tid); }
            GRID_SYNC();
        }
        { FRESH_IDS(); ParamsCP pp = get_params(); unsigned char* ws = pp->ws; float* hmeta = (float*)(ws + WS_HMETA);
          SchedPlain S{(const char*)(ws + WS_BIG + BIG_MERGED), (const char*)(ws + WS_WT + WT_OUT), 4096u, 4096u, 32, 128, 8, 1, G, blk};
          EpiResid E{layer == 0 ? pp->in[0] : (const float*)pp->out, hmeta, pp->out, hmeta}; pg8::gemm_phase(lds, S, E, tid); }
        GRID_SYNC();
        { FRESH_IDS(); ParamsCP pp = get_params(); unsigned char* ws = pp->ws; float* hmeta = (float*)(ws + WS_HMETA);
          if (blk < 8) { SchedPlain S{(const char*)(ws + WS_BIG + BIG_MERGED), (const char*)(ws + WS_WT + WT_OUT), 4096u, 4096u, 32, 1, 8, 0, 8, blk};
                         EpiResid E{layer == 0 ? pp->in[0] : (const float*)pp->out, hmeta, pp->out, hmeta}; pg8::gemm_phase(lds, S, E, tid); }
          else norm_phase(pp, pp->in[18] + layer * D, false, (blk - 8) * 8 + wave, (G - 8) * 8, lane, RB, M); }
        GRID_SYNC();
        { FRESH_IDS(); ParamsCP pp = get_params(); norm_phase(pp, pp->in[18] + layer * D, false, gw, ngw, lane, 0, RB); }
        GRID_SYNC();
        { FRESH_IDS(); ParamsCP pp = get_params(); unsigned char* ws = pp->ws;
          SchedPlain S{(const char*)(ws + WS_U), (const char*)(ws + WS_WT + WT_UP), 4096u, 4096u, 32, 129, 43, 0, G, blk};
          EpiUp E{(bf16_t*)(ws + WS_BIG + BIG_G), (bf16_t*)(ws + WS_BIG + BIG_V)}; pg8::gemm_phase(lds, S, E, tid); }
        GRID_SYNC();
        { FRESH_IDS(); ParamsCP pp = get_params(); act_phase(pp, layer, gtid, ngt); }
        GRID_SYNC();
        { FRESH_IDS(); ParamsCP pp = get_params(); unsigned char* ws = pp->ws; float* hmeta = (float*)(ws + WS_HMETA);
          SchedPlain S{(const char*)(ws + WS_BIG + BIG_V), (const char*)(ws + WS_WT + WT_DOWN), (unsigned)(DFF * 2), (unsigned)(DFF * 2), DFF / 64, 128, 8, 1, G, blk};
          EpiResid E{(const float*)pp->out, hmeta, pp->out, hmeta}; pg8::gemm_phase(lds, S, E, tid); }
        if (layer == 0) {
            GRID_SYNC();
            { FRESH_IDS(); ParamsCP pp = get_params(); unsigned char* ws = pp->ws; float* hmeta = (float*)(ws + WS_HMETA);
              if (blk < 8) { SchedPlain S{(const char*)(ws + WS_BIG + BIG_V), (const char*)(ws + WS_WT + WT_DOWN), (unsigned)(DFF * 2), (unsigned)(DFF * 2), DFF / 64, 1, 8, 0, 8, blk};
                             EpiResid E{(const float*)pp->out, hmeta, pp->out, hmeta}; pg8::gemm_phase(lds, S, E, tid); }
              else convert_weights(pp, 1, lds, (blk - 8) * 8 + wave, (G - 8) * 8, wave, lane, 0, CW_NITEMS - CW_I_DN); }
            GRID_SYNC();
        }
    }
}

constexpr int LDS_BYTES = 131072 + 4096;
extern "C" void kernel_launch(void* const* d_in, const int* in_sizes, int n_in, void* d_out, int out_size, void* d_ws, size_t ws_size, hipStream_t stream) {
    static int grid = 0;
    if (grid == 0) {
        if (n_in != 23 || ws_size < WS_END) { fprintf(stderr, "kernel_launch: need 23 inputs and >= %zu bytes of workspace (got %d, %zu)\n", (size_t)WS_END, n_in, ws_size); grid = -1; return; }
        int dev = 0, cus = 0, per_cu = 0;
        hipGetDevice(&dev);
        hipDeviceGetAttribute(&cus, hipDeviceAttributeMultiprocessorCount, dev);
        if (hipFuncSetAttribute((const void*)fwd_kernel, hipFuncAttributeMaxDynamicSharedMemorySize, LDS_BYTES) != hipSuccess) { fprintf(stderr, "kernel_launch: hipFuncSetAttribute failed\n"); grid = -1; return; }
        if (hipOccupancyMaxActiveBlocksPerMultiprocessor(&per_cu, (const void*)fwd_kernel, 512, LDS_BYTES) != hipSuccess || per_cu < 1) { fprintf(stderr, "kernel_launch: occupancy query failed (%d)\n", per_cu); per_cu = 1; }
        (void)hipGetLastError();
        grid = cus * per_cu; if (grid > 256) grid = 256;
    }
    if (grid < 0) return;
    hipMemsetAsync((char*)d_ws + WS_CTL, 0, CTL_BYTES, stream);
    Params p{};
    for (int i = 0; i < 23; ++i) p.in[i] = (const float*)d_in[i];
    p.out = (float*)d_out; p.ws = (unsigned char*)d_ws;
    void* args[] = {&p};
    hipError_t e = hipLaunchCooperativeKernel((const void*)fwd_kernel, dim3(grid), dim3(512), args, LDS_BYTES, stream);
    if (e != hipSuccess) fprintf(stderr, "cooperative launch failed: %s (grid %d)\n", hipGetErrorString(e), grid);
}
```
